# Optimizing an MI355X kernel written in HIP

```python
import math
import jax, jax.numpy as jnp
from jax import lax
import numpy as np

D_MODEL = 1024
BATCH = 8
SEQ = 8192
DEPTH = 1

CHUNK = 64
MIX_WIDTH = D_MODEL
RET_HEADS = 4
RET_HEAD_DIM = MIX_WIDTH // 8
RET_WIDTH = RET_HEADS * RET_HEAD_DIM
GMLP_GROUPS = 4
GMLP_GROUP_DIM = MIX_WIDTH // 8
GMLP_WIDTH = GMLP_GROUPS * GMLP_GROUP_DIM
GMLP_CHUNK = 128
IN_WIDTH = 4 * RET_WIDTH + 2 * GMLP_WIDTH
D_FF = 2816
ROPE_BASE = 10000.0
LN_EPS = 1e-5
DEEPNORM_ALPHA = (2.0 * DEPTH) ** 0.25
DEEPNORM_BETA = (8.0 * DEPTH) ** -0.25

kernel_name = "hybrid_retention_gmlp_macaron_deepnorm"


def layer_norm(x, g, b):
    xf = x.astype(jnp.float32)
    mu = jnp.mean(xf, axis=-1, keepdims=True)
    var = jnp.mean(jnp.square(xf - mu), axis=-1, keepdims=True)
    return ((xf - mu) * lax.rsqrt(var + LN_EPS) * g.astype(jnp.float32) + b.astype(jnp.float32)).astype(x.dtype)


def swiglu_ffn(x, w_in, w_out):
    gate, up = jnp.split(x @ w_in, 2, axis=-1)
    return (jax.nn.silu(gate) * up) @ w_out


def rotary(x, positions):
    d = x.shape[-1]
    inv_freq = ROPE_BASE ** (-jnp.arange(0, d, 2, dtype=jnp.float32) / d)
    ang = positions.astype(jnp.float32)[:, None] * inv_freq[None, :]
    cos = jnp.cos(ang)[None, :, None, :]
    sin = jnp.sin(ang)[None, :, None, :]
    x1, x2 = jnp.split(x.astype(jnp.float32), 2, axis=-1)
    return jnp.concatenate([x1 * cos - x2 * sin, x1 * sin + x2 * cos], axis=-1)


def chunkwise_retention(q, k, v):
    B_, S_, H, dk = q.shape
    dv = v.shape[-1]
    n = S_ // CHUNK
    log_gamma = jnp.log1p(-(2.0 ** (-5.0 - jnp.arange(H, dtype=jnp.float32))))
    idx = jnp.arange(CHUNK, dtype=jnp.float32)
    rel = idx[:, None] - idx[None, :]
    decay_intra = jnp.where(rel[None] >= 0,
                            jnp.exp(jnp.maximum(rel, 0.0)[None] * log_gamma[:, None, None]), 0.0)
    xi = jnp.exp((idx + 1.0)[None, :] * log_gamma[:, None])
    zeta = jnp.exp((CHUNK - 1.0 - idx)[None, :] * log_gamma[:, None])
    gamma_chunk = jnp.exp(CHUNK * log_gamma)

    qc = q.reshape(B_, n, CHUNK, H, dk)
    kc = k.reshape(B_, n, CHUNK, H, dk)
    vc = v.reshape(B_, n, CHUNK, H, dv)

    scores = jnp.einsum('bnihd,bnjhd->bnhij', qc, kc) * decay_intra[None, None]
    intra = jnp.einsum('bnhij,bnjhe->bnihe', scores, vc)

    kv = jnp.einsum('bnjhd,bnjhe->nbhde', kc, vc * zeta.T[None, None, :, :, None])

    def step(state, inp):
        q_i, kv_i = inp
        cross = jnp.einsum('bihd,bhde->bihe', q_i, state)
        return gamma_chunk[None, :, None, None] * state + kv_i, cross

    state0 = jnp.zeros((B_, H, dk, dv), jnp.float32)
    _, cross = lax.scan(step, state0, (jnp.moveaxis(qc, 1, 0), kv))
    cross = jnp.moveaxis(cross, 0, 1) * xi.T[None, None, :, :, None]
    return (intra + cross).reshape(B_, S_, H, dv)


def spatial_gating(u, z, g_v, b_v, w_s, b_s):
    B_, S_, G, c = z.shape
    n = S_ // GMLP_CHUNK
    z = layer_norm(z, g_v, b_v)
    mask = jnp.tril(jnp.ones((GMLP_CHUNK, GMLP_CHUNK), dtype=bool))
    w = jnp.where(mask[None], w_s, 0.0).astype(z.dtype)
    zc = z.reshape(B_, n, GMLP_CHUNK, G, c)
    mixed = jnp.einsum('gts,bnsgc->bntgc', w, zc) + b_s.T.astype(z.dtype)[None, None, :, :, None]
    return u * mixed.reshape(B_, S_, G, c)


def hybrid_mixer(h, w_in, ret_gn_g, ret_gn_b, gmlp_ln_g, gmlp_ln_b, gmlp_w_s, gmlp_b_s, w_out):
    B_, S_, _ = h.shape
    proj = h @ w_in
    q, k, v, g, u, z = jnp.split(
        proj, [RET_WIDTH, 2 * RET_WIDTH, 3 * RET_WIDTH, 4 * RET_WIDTH, 4 * RET_WIDTH + GMLP_WIDTH], axis=-1)

    positions = jnp.arange(S_, dtype=jnp.int32)
    qh = rotary(q.reshape(B_, S_, RET_HEADS, RET_HEAD_DIM), positions)
    kh = rotary(k.reshape(B_, S_, RET_HEADS, RET_HEAD_DIM), positions) * (RET_HEAD_DIM ** -0.5)
    vh = v.reshape(B_, S_, RET_HEADS, RET_HEAD_DIM).astype(jnp.float32)
    ret = chunkwise_retention(qh, kh, vh)
    ret = layer_norm(ret, ret_gn_g, ret_gn_b).astype(h.dtype)
    ret = jax.nn.silu(g) * ret.reshape(B_, S_, RET_WIDTH)

    u = jax.nn.gelu(u, approximate=False).reshape(B_, S_, GMLP_GROUPS, GMLP_GROUP_DIM)
    z = jax.nn.gelu(z, approximate=False).reshape(B_, S_, GMLP_GROUPS, GMLP_GROUP_DIM)
    sg = spatial_gating(u, z, gmlp_ln_g, gmlp_ln_b, gmlp_w_s, gmlp_b_s).reshape(B_, S_, GMLP_WIDTH)

    return jnp.concatenate([ret, sg], axis=-1) @ w_out


def setup_inputs(seed: int = 0) -> dict:
    key = jax.random.key(seed)
    ks = jax.random.split(key, 20)
    f32 = jnp.float32
    nrm = lambda k, shape, s: jax.random.normal(k, shape, f32) * s
    x = nrm(ks[0], (BATCH, SEQ, D_MODEL), 1.0)
    ffn1_w_in = nrm(ks[1], (DEPTH, D_MODEL, 2 * D_FF), D_MODEL ** -0.5)
    ffn1_w_out = nrm(ks[2], (DEPTH, D_FF, D_MODEL), D_FF ** -0.5 * DEEPNORM_BETA)
    ln1_g = 1.0 + nrm(ks[3], (DEPTH, D_MODEL), 0.02)
    ln1_b = nrm(ks[4], (DEPTH, D_MODEL), 0.02)
    mix_w_in = nrm(ks[5], (DEPTH, D_MODEL, IN_WIDTH), D_MODEL ** -0.5)
    mix_w_in = mix_w_in.at[:, :, 2 * RET_WIDTH:3 * RET_WIDTH].multiply(DEEPNORM_BETA)
    ret_gn_g = 1.0 + nrm(ks[6], (DEPTH, RET_HEADS, RET_HEAD_DIM), 0.02)
    ret_gn_b = nrm(ks[7], (DEPTH, RET_HEADS, RET_HEAD_DIM), 0.02)
    gmlp_ln_g = 1.0 + nrm(ks[8], (DEPTH, GMLP_GROUPS, GMLP_GROUP_DIM), 0.02)
    gmlp_ln_b = nrm(ks[9], (DEPTH, GMLP_GROUPS, GMLP_GROUP_DIM), 0.02)
    gmlp_w_s = nrm(ks[10], (DEPTH, GMLP_GROUPS, GMLP_CHUNK, GMLP_CHUNK), GMLP_CHUNK ** -0.5)
    gmlp_b_s = 1.0 + nrm(ks[11], (DEPTH, GMLP_GROUPS, GMLP_CHUNK), 0.02)
    mix_w_out = nrm(ks[12], (DEPTH, MIX_WIDTH, D_MODEL), MIX_WIDTH ** -0.5 * DEEPNORM_BETA)
    ln2_g = 1.0 + nrm(ks[13], (DEPTH, D_MODEL), 0.02)
    ln2_b = nrm(ks[14], (DEPTH, D_MODEL), 0.02)
    ffn2_w_in = nrm(ks[15], (DEPTH, D_MODEL, 2 * D_FF), D_MODEL ** -0.5)
    ffn2_w_out = nrm(ks[16], (DEPTH, D_FF, D_MODEL), D_FF ** -0.5 * DEEPNORM_BETA)
    ln3_g = 1.0 + nrm(ks[17], (DEPTH, D_MODEL), 0.02)
    ln3_b = nrm(ks[18], (DEPTH, D_MODEL), 0.02)
    return {"x": x, "ffn1_w_in": ffn1_w_in, "ffn1_w_out": ffn1_w_out, "ln1_g": ln1_g, "ln1_b": ln1_b,
            "mix_w_in": mix_w_in, "ret_gn_g": ret_gn_g, "ret_gn_b": ret_gn_b,
            "gmlp_ln_g": gmlp_ln_g, "gmlp_ln_b": gmlp_ln_b, "gmlp_w_s": gmlp_w_s, "gmlp_b_s": gmlp_b_s,
            "mix_w_out": mix_w_out, "ln2_g": ln2_g, "ln2_b": ln2_b,
            "ffn2_w_in": ffn2_w_in, "ffn2_w_out": ffn2_w_out, "ln3_g": ln3_g, "ln3_b": ln3_b}


def reference(x, ffn1_w_in, ffn1_w_out, ln1_g, ln1_b, mix_w_in, ret_gn_g, ret_gn_b,
              gmlp_ln_g, gmlp_ln_b, gmlp_w_s, gmlp_b_s, mix_w_out, ln2_g, ln2_b,
              ffn2_w_in, ffn2_w_out, ln3_g, ln3_b):
    for l in range(DEPTH):
        x = layer_norm(DEEPNORM_ALPHA * x + 0.5 * swiglu_ffn(x, ffn1_w_in[l], ffn1_w_out[l]), ln1_g[l], ln1_b[l])
        mix = hybrid_mixer(x, mix_w_in[l], ret_gn_g[l], ret_gn_b[l], gmlp_ln_g[l], gmlp_ln_b[l],
                           gmlp_w_s[l], gmlp_b_s[l], mix_w_out[l])
        x = layer_norm(DEEPNORM_ALPHA * x + mix, ln2_g[l], ln2_b[l])
        x = layer_norm(DEEPNORM_ALPHA * x + 0.5 * swiglu_ffn(x, ffn2_w_in[l], ffn2_w_out[l]), ln3_g[l], ln3_b[l])
    return x
```

```cpp
#include <hip/hip_runtime.h>
#include <hip/hip_cooperative_groups.h>
#include <cstdio>
#include <cstdint>
namespace cg = cooperative_groups;
namespace pg8 {
#define PG8_LAS __attribute__((address_space(3)))
typedef unsigned short bf16_t;
typedef short bf16x8 __attribute__((ext_vector_type(8)));
typedef float f32x4 __attribute__((ext_vector_type(4)));
typedef unsigned u32x4 __attribute__((ext_vector_type(4)));
constexpr int BM = 256, BK = 64, HALF = 128, HTB = HALF * BK * 2  , STAGE_BYTES = 8 * HTB, NXCD = 8, WGM = 8;

__host__ __device__ __forceinline__ int lds_byte(int r, int c) { const int st = (r >> 4) * 2 + (c >> 5), rr = r & 15, cc = c & 31, ob = rr * 64 + cc * 2; return st * 1024 + (ob ^ (((ob >> 9) & 1) << 5)); }
__host__ __device__ __forceinline__ void stage_rc(int b, int& R, int& C) { const int st = b / 1024, sb = b % 1024, swz = sb ^ (((sb >> 9) & 1) << 5); R = (st >> 1) * 16 + swz / 64; C = (st & 1) * 32 + (swz % 64) / 2; }
__host__ __device__ __forceinline__ int perm32(int rho) { const int n = rho >> 4, i = rho & 15; return 8 * (i >> 2) + 4 * n + (i & 3); }

struct Unit { int pm, pn; };
struct Gemm { const bf16_t* A; const bf16_t* Bt; int M, N, K; };

struct StaticOrder {
    int nM, nN, nwg, G, c;
    __host__ __device__ void init(int M, int N, int G_, int c_) { nM = M / BM; nN = N / BM; nwg = nM * nN; G = G_; c = c_; }
    __host__ __device__ bool next(int i, Unit& u) const {
        const long L = (long)i * G + c; if (L >= nwg) return false;
        int wgid = (int)L; { const int q = nwg / NXCD, r = nwg % NXCD, xcd = wgid % NXCD, off = wgid / NXCD; wgid = (xcd < r ? xcd * (q + 1) : r * (q + 1) + (xcd - r) * q) + off; }
        const int nig = WGM * nN, gid = wgid / nig, fm = gid * WGM, gsz = (nM - fm) < WGM ? (nM - fm) : WGM;
        u.pm = fm + ((wgid % nig) % gsz); u.pn = (wgid % nig) / gsz; return true;
    }
    __device__ __forceinline__ void a_ready(const Unit&) const {}
    __device__ __forceinline__ void done(const Unit&) const {}
};
__device__ __forceinline__ unsigned cvt_pk_bf16(float lo, float hi) { unsigned r; asm volatile("v_cvt_pk_bf16_f32 %0, %1, %2" : "=v"(r) : "v"(lo), "v"(hi)); return r; }
typedef float f32x2 __attribute__((ext_vector_type(2)));
__device__ __forceinline__ f32x2 gelu_pk(f32x2 v) {
    const f32x2 av = __builtin_elementwise_abs(v), d = av * 0.2316418882f + 1.0f;
    f32x2 t; t.x = __builtin_amdgcn_rcpf(d.x); t.y = __builtin_amdgcn_rcpf(d.y);
    f32x2 q = t * 0.5307027145f + (-0.7265760135f); q = q * t + 0.7107068705f; q = q * t + (-0.142248368f); q = q * t + 0.127414796f; q = q * t;
    const f32x2 s = (v * v) * (-0.72134752044f);
    f32x2 e; e.x = __builtin_amdgcn_exp2f(s.x); e.y = __builtin_amdgcn_exp2f(s.y);
    const f32x2 m = v * (q * e), r = v - m;
    f32x2 o; o.x = v.x < 0.f ? m.x : r.x; o.y = v.y < 0.f ? m.y : r.y; return o;
}
__device__ __forceinline__ float fast_silu(float g) { return g * __builtin_amdgcn_rcpf(1.0f + __builtin_amdgcn_exp2f(-1.4426950408889634f * g)); }
__device__ __forceinline__ float bf2f(unsigned short b) { return __uint_as_float(((unsigned)b) << 16); }
typedef unsigned u32x2 __attribute__((ext_vector_type(2)));

struct EpiUp {
    static constexpr bool PERM = false, AFTER_DRAIN = false;
    bf16_t* H; int ldh;
    __device__ __forceinline__ void operator()(const f32x4 (&acc)[2][2][4][2], const Unit& u, int wr, int wc, int fr, int fq) const {
        const int row0 = u.pm * BM + wr * 64 + fr, col0 = u.pn * 128 + wc * 32 + 8 * fq;
#pragma unroll
        for (int ai = 0; ai < 2; ++ai)
#pragma unroll
            for (int m = 0; m < 4; ++m) {
                bf16_t* p = H + (size_t)(row0 + ai * HALF + m * 16) * ldh + col0;
                float h[8];
#pragma unroll
                for (int n = 0; n < 2; ++n)
#pragma unroll
                    for (int j = 0; j < 4; ++j) h[n * 4 + j] = fast_silu(acc[ai][0][m][n][j]) * acc[ai][1][m][n][j];
                u32x4 w; w.x = cvt_pk_bf16(h[0], h[1]); w.y = cvt_pk_bf16(h[2], h[3]); w.z = cvt_pk_bf16(h[4], h[5]); w.w = cvt_pk_bf16(h[6], h[7]);
                *(u32x4*)p = w;
            }
    }
};
struct EpiRes {
    static constexpr bool PERM = false, AFTER_DRAIN = false;
    const float* res; float* out; float alpha, scale;
    __device__ __forceinline__ void operator()(const f32x4 (&acc)[2][2][4][2], const Unit& u, int wr, int wc, int fr, int fq) const {
        const int row0 = u.pm * BM + wr * 64 + fr, col0 = u.pn * BM + wc * 32 + 4 * fq;
#pragma unroll
        for (int ai = 0; ai < 2; ++ai)
#pragma unroll
            for (int m = 0; m < 4; ++m) {
                const size_t off = (size_t)(row0 + ai * HALF + m * 16) * 1024 + col0;
                f32x4 r[2][2];
#pragma unroll
                for (int bj = 0; bj < 2; ++bj)
#pragma unroll
                    for (int n = 0; n < 2; ++n) r[bj][n] = *(const f32x4*)(res + off + bj * HALF + n * 16);
#pragma unroll
                for (int bj = 0; bj < 2; ++bj)
#pragma unroll
                    for (int n = 0; n < 2; ++n) *(f32x4*)(out + off + bj * HALF + n * 16) = r[bj][n] * alpha + acc[ai][bj][m][n] * scale;
            }
    }
};
struct EpiIn {
    static constexpr bool PERM = false, AFTER_DRAIN = false;
    bf16_t *Qt, *Kt, *KTz, *VT, *G, *U, *ZT; const float* rope;
    __device__ __forceinline__ void operator()(const f32x4 (&acc)[2][2][4][2], const Unit& u, int wr, int wc, int fr, int fq) const {
        const int sec = u.pn >> 1, half = u.pn & 1;
        const int rowb = u.pm * BM + wr * 64 + fr;
        if (sec <= 1) {
#pragma unroll
            for (int ai = 0; ai < 2; ++ai)
#pragma unroll
                for (int m = 0; m < 4; ++m) {
                    const int row = rowb + ai * HALF + m * 16, ip = row & 255, pos = row & 8191, bb = row >> 13;
                    const int i0 = 16 * wc + 4 * fq;
                    const f32x4 c4 = *(const f32x4*)(rope + (size_t)pos * 64 + i0), s4 = *(const f32x4*)(rope + (size_t)(8192 + pos) * 64 + i0);
#pragma unroll
                    for (int bj = 0; bj < 2; ++bj) {
                        const int head = half * 2 + bj;
                        const float lg = head == 0 ? -0.04580368961312479f : head == 1 ? -0.02272007650008353f : head == 2 ? -0.011315313227834146f : -0.005646563141142063f;
                        const f32x4 x1 = acc[ai][bj][m][0], x2 = acc[ai][bj][m][1];
                        const f32x4 o1 = x1 * c4 - x2 * s4, o2 = x1 * s4 + x2 * c4;
                        if (sec == 0) {
                            const float f = __builtin_amdgcn_exp2f((float)ip * lg);
                            bf16_t* p = Qt + (size_t)row * 512 + head * 128 + i0;
                            u32x2 w1, w2; w1.x = cvt_pk_bf16(o1[0] * f, o1[1] * f); w1.y = cvt_pk_bf16(o1[2] * f, o1[3] * f);
                            w2.x = cvt_pk_bf16(o2[0] * f, o2[1] * f); w2.y = cvt_pk_bf16(o2[2] * f, o2[3] * f);
                            *(u32x2*)p = w1; *(u32x2*)(p + 64) = w2;
                        } else {
                            const float f1 = 0.08838834764831845f * __builtin_amdgcn_exp2f(-(float)ip * lg);
                            const float f2 = 0.08838834764831845f * __builtin_amdgcn_exp2f((float)(255 - ip) * lg);
                            bf16_t* p = Kt + (size_t)row * 512 + head * 128 + i0;
                            u32x2 w1, w2; w1.x = cvt_pk_bf16(o1[0] * f1, o1[1] * f1); w1.y = cvt_pk_bf16(o1[2] * f1, o1[3] * f1);
                            w2.x = cvt_pk_bf16(o2[0] * f1, o2[1] * f1); w2.y = cvt_pk_bf16(o2[2] * f1, o2[3] * f1);
                            *(u32x2*)p = w1; *(u32x2*)(p + 64) = w2;
                            bf16_t* t = KTz + ((size_t)((bb * 4 + head) * 128 + i0)) * 8192 + pos;
#pragma unroll
                            for (int j = 0; j < 4; ++j) {
                                t[(size_t)j * 8192] = (bf16_t)(cvt_pk_bf16(o1[j] * f2, 0.f) & 0xffffu);
                                t[(size_t)(64 + j) * 8192] = (bf16_t)(cvt_pk_bf16(o2[j] * f2, 0.f) & 0xffffu);
                            }
                        }
                    }
                }
        } else if (sec == 2 || sec == 5) {
            bf16_t* T = sec == 2 ? VT : ZT;
#pragma unroll
            for (int ai = 0; ai < 2; ++ai)
#pragma unroll
                for (int m = 0; m < 4; ++m) {
                    const int row = rowb + ai * HALF + m * 16, pos = row & 8191, bb = row >> 13;
#pragma unroll
                    for (int bj = 0; bj < 2; ++bj) {
                        const int grp = half * 2 + bj;
#pragma unroll
                        for (int n = 0; n < 2; ++n) {
                            f32x4 v = acc[ai][bj][m][n];
                            int ch;
                            if (sec == 5) { f32x2 a = gelu_pk((f32x2){v[0], v[1]}), b = gelu_pk((f32x2){v[2], v[3]}); v = (f32x4){a.x, a.y, b.x, b.y}; ch = wc * 32 + 8 * fq + 4 * n; }
                            else ch = wc * 32 + 16 * n + 4 * fq;
                            bf16_t* t = T + ((size_t)((bb * 4 + grp) * 128 + ch)) * 8192 + pos;
#pragma unroll
                            for (int j = 0; j < 4; ++j) t[(size_t)j * 8192] = (bf16_t)(cvt_pk_bf16(v[j], 0.f) & 0xffffu);
                        }
                    }
                }
        } else {
            bf16_t* O = sec == 3 ? G : U;
#pragma unroll
            for (int ai = 0; ai < 2; ++ai)
#pragma unroll
                for (int m = 0; m < 4; ++m) {
                    const int row = rowb + ai * HALF + m * 16;
#pragma unroll
                    for (int bj = 0; bj < 2; ++bj) {
                        f32x4 v0 = acc[ai][bj][m][0], v1 = acc[ai][bj][m][1];
                        if (sec == 3) {
#pragma unroll
                            for (int j = 0; j < 4; ++j) { v0[j] = fast_silu(v0[j]); v1[j] = fast_silu(v1[j]); }
                        } else {
                            f32x2 a = gelu_pk((f32x2){v0[0], v0[1]}), b = gelu_pk((f32x2){v0[2], v0[3]}), c = gelu_pk((f32x2){v1[0], v1[1]}), d = gelu_pk((f32x2){v1[2], v1[3]});
                            v0 = (f32x4){a.x, a.y, b.x, b.y}; v1 = (f32x4){c.x, c.y, d.x, d.y};
                        }
                        u32x4 w; w.x = cvt_pk_bf16(v0[0], v0[1]); w.y = cvt_pk_bf16(v0[2], v0[3]); w.z = cvt_pk_bf16(v1[0], v1[1]); w.w = cvt_pk_bf16(v1[2], v1[3]);
                        *(u32x4*)(O + (size_t)row * 512 + half * 256 + bj * 128 + wc * 32 + 8 * fq) = w;
                    }
                }
        }
    }
};
template <class Epi, class Sched, bool ALIGN_EPI = false, bool SP2 = false>
__device__ __forceinline__ void gemm_phase(PG8_LAS unsigned char* lds, const Gemm g, const Sched& S, const Epi& E) {
    const int tid = threadIdx.x, wid = __builtin_amdgcn_readfirstlane(tid >> 6), lane = tid & 63, wr = wid >> 2, wc = wid & 3, fr = lane & 15, fq = lane >> 4;
    const int K = g.K, nt = K / BK;
    unsigned voffA[2], voffB[2];
#pragma unroll
    for (int i = 0; i < 2; ++i) { int R, C; stage_rc(tid * 16 + i * 8192, R, C); const int Rb = Epi::PERM ? ((R & ~31) + perm32(R & 31)) : R;
        voffA[i] = (unsigned)(R * K + C) * 2u; voffB[i] = (unsigned)(Rb * K + C) * 2u; }
    const size_t kstep = (size_t)(BK * 2);
    const size_t hstep = (size_t)HALF * K * 2;
    const size_t tstep = 2 * hstep;
    const unsigned ldsw = (unsigned)wid * 1024u;
    const int aoff = lds_byte(wr * 64 + fr, fq * 8), boff = lds_byte(wc * 32 + fr, fq * 8);
#define PG8_SA(b, h) (((b) * 2 + (h)) * HTB)
#define PG8_SB(b, h) ((4 + (b) * 2 + (h)) * HTB)
#define PG8_STAGE(bufoff, gbase, voff) do { _Pragma("unroll") for (int _i = 0; _i < 2; ++_i) \
        __builtin_amdgcn_global_load_lds((const unsigned*)((const char*)(gbase) + (voff)[_i]), (PG8_LAS unsigned*)(lds + (bufoff) + ldsw + _i * 8192), 16, 0, 0); } while (0)
#define PG8_LDA(dst, b, h) do { _Pragma("unroll") for (int m = 0; m < 4; ++m) _Pragma("unroll") for (int k = 0; k < 2; ++k) dst[m][k] = *(const PG8_LAS bf16x8*)(lds + PG8_SA(b, h) + aoff + m * 2048 + k * 1024); } while (0)
#define PG8_LDB(dst, b, h) do { _Pragma("unroll") for (int n = 0; n < 2; ++n) _Pragma("unroll") for (int k = 0; k < 2; ++k) dst[n][k] = *(const PG8_LAS bf16x8*)(lds + PG8_SB(b, h) + boff + n * 2048 + k * 1024); } while (0)
#define PG8_MMA(ai, bj, At, Bt) do { __builtin_amdgcn_s_setprio(1); _Pragma("unroll") for (int m = 0; m < 4; ++m) _Pragma("unroll") for (int n = 0; n < 2; ++n) _Pragma("unroll") for (int k = 0; k < 2; ++k) \
        acc[ai][bj][m][n] = __builtin_amdgcn_mfma_f32_16x16x32_bf16(Bt[n][k], At[m][k], acc[ai][bj][m][n], 0, 0, 0); __builtin_amdgcn_s_setprio(0); } while (0)
#define PG8_WAIT_V(n) asm volatile("s_waitcnt vmcnt(" #n ")" ::: "memory")
#define PG8_WAIT_L(n) asm volatile("s_waitcnt lgkmcnt(" #n ")" ::: "memory")
#define PG8_BAR __builtin_amdgcn_s_barrier()
#define PG8_SCHED __builtin_amdgcn_sched_barrier(0)
    Unit cur, nxt; int ui = 0;
    if (!S.next(0, cur)) return;
    f32x4 acc[2][2][4][2];
#pragma unroll
    for (int a = 0; a < 2; ++a)
#pragma unroll
        for (int b = 0; b < 2; ++b)
#pragma unroll
            for (int m = 0; m < 4; ++m)
#pragma unroll
                for (int n = 0; n < 2; ++n) acc[a][b][m][n] = (f32x4){0.f, 0.f, 0.f, 0.f};
    bf16x8 At[4][2], B0[2][2], B1[2][2];
    const char* cA = (const char*)g.A + (size_t)cur.pm * tstep; const char* cB = (const char*)g.Bt + (size_t)cur.pn * tstep;
    S.a_ready(cur);
    if constexpr (SP2) {
        PG8_STAGE(PG8_SB(0, 0), cB, voffB); PG8_STAGE(PG8_SB(0, 1), cB + hstep, voffB); PG8_STAGE(PG8_SA(0, 0), cA, voffA); PG8_STAGE(PG8_SA(0, 1), cA + hstep, voffA);
        if (wr == 1) PG8_BAR;
        PG8_WAIT_V(2); PG8_BAR;
        PG8_STAGE(PG8_SB(1, 0), cB + kstep, voffB); PG8_STAGE(PG8_SA(1, 0), cA + kstep, voffA); PG8_STAGE(PG8_SB(1, 1), cB + hstep + kstep, voffB);
        PG8_WAIT_V(6); PG8_BAR;
    } else {
        PG8_STAGE(PG8_SB(0, 0), cB, voffB); PG8_STAGE(PG8_SA(0, 0), cA, voffA); PG8_STAGE(PG8_SB(0, 1), cB + hstep, voffB); PG8_STAGE(PG8_SA(0, 1), cA + hstep, voffA);
        if (wr == 1) PG8_BAR;
        PG8_WAIT_V(4); PG8_BAR;
        PG8_STAGE(PG8_SB(1, 0), cB + kstep, voffB); PG8_STAGE(PG8_SA(1, 0), cA + kstep, voffA); PG8_STAGE(PG8_SB(1, 1), cB + hstep + kstep, voffB);
        PG8_WAIT_V(6); PG8_BAR;
    }
    for (;;) {
        const bool has_next = S.next(ui + 1, nxt);
        const char* nA = has_next ? (const char*)g.A + (size_t)nxt.pm * tstep : cA; const char* nB = has_next ? (const char*)g.Bt + (size_t)nxt.pn * tstep : cB;
        for (int t = 0; t < nt; t += 2) {
            const bool last = (t == nt - 2);
            const char* a1 = cA + (size_t)(t + 1) * kstep;
            const char* a2 = last ? nA : cA + (size_t)(t + 2) * kstep; const char* b2 = last ? nB : cB + (size_t)(t + 2) * kstep;
            const char* a3 = a2 + kstep; const char* b3 = b2 + kstep;
            if (last && has_next) S.a_ready(nxt);
            if constexpr (SP2) {
            PG8_LDB(B0, 0, 0); PG8_LDB(B1, 0, 1); PG8_SCHED; PG8_LDA(At, 0, 0); PG8_STAGE(PG8_SA(1, 1), a1 + hstep, voffA);
            PG8_WAIT_V(8); PG8_WAIT_L(0); PG8_BAR; PG8_MMA(0, 0, At, B0); PG8_MMA(0, 1, At, B1); PG8_BAR; PG8_SCHED;
            PG8_LDA(At, 0, 1); PG8_STAGE(PG8_SB(0, 0), b2, voffB); PG8_STAGE(PG8_SB(0, 1), b2 + hstep, voffB); PG8_STAGE(PG8_SA(0, 0), a2, voffA);
            PG8_WAIT_V(8); PG8_WAIT_L(0); PG8_BAR; PG8_MMA(1, 0, At, B0); PG8_MMA(1, 1, At, B1); PG8_BAR; PG8_SCHED;
            PG8_LDB(B0, 1, 0); PG8_LDB(B1, 1, 1); PG8_SCHED; PG8_LDA(At, 1, 0); PG8_STAGE(PG8_SA(0, 1), a2 + hstep, voffA);
            PG8_WAIT_V(8); PG8_WAIT_L(0); PG8_BAR; PG8_MMA(0, 0, At, B0); PG8_MMA(0, 1, At, B1); PG8_BAR; PG8_SCHED;
            PG8_LDA(At, 1, 1); PG8_STAGE(PG8_SB(1, 0), b3, voffB); PG8_STAGE(PG8_SB(1, 1), b3 + hstep, voffB); PG8_STAGE(PG8_SA(1, 0), a3, voffA);
            PG8_WAIT_V(8); PG8_WAIT_L(0); PG8_BAR; PG8_MMA(1, 0, At, B0); PG8_MMA(1, 1, At, B1); PG8_BAR; PG8_SCHED;
            } else {
            PG8_LDB(B0, 0, 0); PG8_SCHED; PG8_LDA(At, 0, 0); PG8_STAGE(PG8_SA(1, 1), a1 + hstep, voffA);
            PG8_WAIT_L(8); PG8_BAR; PG8_WAIT_L(0); PG8_MMA(0, 0, At, B0); PG8_BAR; PG8_SCHED;
            PG8_LDB(B1, 0, 1); PG8_STAGE(PG8_SB(0, 0), b2, voffB);
            PG8_BAR; PG8_WAIT_L(0); PG8_MMA(0, 1, At, B1); PG8_BAR;
            PG8_LDA(At, 0, 1); PG8_STAGE(PG8_SA(0, 0), a2, voffA);
            PG8_BAR; PG8_WAIT_L(0); PG8_MMA(1, 0, At, B0); PG8_BAR; PG8_SCHED;
            PG8_STAGE(PG8_SB(0, 1), b2 + hstep, voffB);
            PG8_WAIT_V(6); PG8_BAR; PG8_MMA(1, 1, At, B1); PG8_BAR;
            PG8_LDB(B0, 1, 0); PG8_SCHED; PG8_LDA(At, 1, 0); PG8_STAGE(PG8_SA(0, 1), a2 + hstep, voffA);
            PG8_WAIT_L(8); PG8_BAR; PG8_WAIT_L(0); PG8_MMA(0, 0, At, B0); PG8_BAR; PG8_SCHED;
            PG8_LDB(B1, 1, 1); PG8_STAGE(PG8_SB(1, 0), b3, voffB);
            PG8_BAR; PG8_WAIT_L(0); PG8_MMA(0, 1, At, B1); PG8_BAR;
            PG8_LDA(At, 1, 1); PG8_STAGE(PG8_SA(1, 0), a3, voffA);
            PG8_BAR; PG8_WAIT_L(0); PG8_MMA(1, 0, At, B0); PG8_BAR; PG8_SCHED;
            PG8_STAGE(PG8_SB(1, 1), b3 + hstep, voffB);
            PG8_WAIT_V(6); PG8_BAR; PG8_MMA(1, 1, At, B1); PG8_BAR;
            }
        }
        if constexpr (ALIGN_EPI) { if (wr == 0) PG8_BAR; }
        if constexpr (!Epi::AFTER_DRAIN) { E(acc, cur, wr, wc, fr, fq); S.done(cur); }
        if (!has_next) break;
#pragma unroll
        for (int a = 0; a < 2; ++a)
#pragma unroll
            for (int b = 0; b < 2; ++b)
#pragma unroll
                for (int m = 0; m < 4; ++m)
#pragma unroll
                    for (int n = 0; n < 2; ++n) acc[a][b][m][n] = (f32x4){0.f, 0.f, 0.f, 0.f};
        cur = nxt; cA = nA; cB = nB; ++ui;
        if constexpr (ALIGN_EPI) { if (wr == 1) PG8_BAR; }
    }
    PG8_WAIT_V(0);
    if constexpr (!ALIGN_EPI) { if (wr == 0) PG8_BAR; }
    PG8_BAR;
    if constexpr (Epi::AFTER_DRAIN) { E.fused(acc, cur, wr, wc, fr, fq, lds, wid, lane); S.done(cur); }
#undef PG8_SA
#undef PG8_SB
#undef PG8_STAGE
#undef PG8_LDA
#undef PG8_LDB
#undef PG8_MMA
#undef PG8_WAIT_V
#undef PG8_WAIT_L
#undef PG8_BAR
#undef PG8_SCHED
}
}
constexpr int NWAVES = 8;
constexpr int BATCH = 8, SEQ = 8192, D = 1024, FF = 2816, NUP = 2 * FF, NIN = 3072, MW = 512;
constexpr int M = BATCH * SEQ;
constexpr float LN_EPS = 1e-5f, ALPHA = 1.189207115002721f;
constexpr int RC = 256, NCH = SEQ / RC;
constexpr size_t MiB = 1u << 20;
constexpr size_t WS_W1U = 1 * MiB, WS_W1D = 12 * MiB, WS_WIN = 18 * MiB, WS_WOUT = 24 * MiB, WS_W2U = 26 * MiB, WS_W2D = 37 * MiB;
constexpr size_t WS_TRIL = 43 * MiB, WS_ROPE = 44 * MiB;
constexpr size_t WS_XB = 64 * MiB;
constexpr size_t WS_R = 192 * MiB;
constexpr size_t WS_H = WS_R;
constexpr size_t WS_QT = WS_R, WS_KT = WS_R + 64 * MiB, WS_KTZ = WS_R + 128 * MiB, WS_VT = WS_R + 192 * MiB, WS_G = WS_R + 256 * MiB, WS_U = WS_R + 320 * MiB, WS_ZT = WS_R + 384 * MiB;
constexpr size_t WS_KV = 640 * MiB, WS_ST = 704 * MiB;
constexpr size_t WS_CAT = 768 * MiB, WS_END = 896 * MiB;
static_assert(WS_H + (size_t)M * FF * 2 <= WS_KV && WS_ZT + 64 * MiB <= WS_KV, "ws map");
constexpr int LDS_BYTES = 147456;

#define GAS __attribute__((address_space(1)))
#define LAS __attribute__((address_space(3)))
typedef unsigned short bf16;
typedef unsigned v4u __attribute__((ext_vector_type(4)));
typedef unsigned v2u __attribute__((ext_vector_type(2)));
typedef float f32x4 __attribute__((ext_vector_type(4)));
typedef short bf16x8 __attribute__((ext_vector_type(8)));
using pg8::cvt_pk_bf16; using pg8::bf2f; using pg8::fast_silu;
#define LDS_WAIT() asm volatile("s_waitcnt lgkmcnt(0)" ::: "memory")

__device__ __forceinline__ float wave_sum(float v) {
#pragma unroll
    for (int o = 1; o < 64; o <<= 1) v += __shfl_xor(v, o);
    return v;
}
__device__ __forceinline__ int inv_perm32(int x) { return ((x & 7) >> 2) * 16 + (x >> 3) * 4 + (x & 3); }
__device__ __forceinline__ int phys_up(int c) { const int bj = c / FF, h = c % FF; return (h >> 7) * 256 + bj * 128 + (h & 96) + inv_perm32(h & 31); }
__device__ __forceinline__ int phys_in(int c) {
    const int s = c >> 9, q = c & 511;
    if (s <= 1) { const int hh = q >> 7, dim = q & 127, n = dim >> 6, i = dim & 63; return (s << 9) + (hh << 7) + 32 * (i >> 4) + 16 * n + (i & 15); }
    if (s == 2) return c;
    return (c & ~31) + inv_perm32(c & 31);
}
template <int MAP> __device__ __forceinline__ void p0_transpose_item(const float* W, int K, int N, bf16* WT, LAS float* scr, int item, int lane) {
    const int nblk = N / 32, kb = item / nblk, nb = item % nblk, k0 = 64 * kb, n0 = 32 * nb;
#pragma unroll 8
    for (int i = 0; i < 32; ++i) { const int kk = 2 * i + (lane >> 5); scr[kk * 33 + (lane & 31)] = W[(size_t)(k0 + kk) * N + n0 + (lane & 31)]; }
    LDS_WAIT(); asm volatile("" ::: "memory");
    const int c = lane & 7;
#pragma unroll
    for (int j = 0; j < 4; ++j) { const int n = (lane >> 3) + 8 * j; const LAS float* s = scr + (8 * c) * 33 + n;
        v4u o; o.x = cvt_pk_bf16(s[0 * 33], s[1 * 33]); o.y = cvt_pk_bf16(s[2 * 33], s[3 * 33]); o.z = cvt_pk_bf16(s[4 * 33], s[5 * 33]); o.w = cvt_pk_bf16(s[6 * 33], s[7 * 33]);
        const int col = n0 + n, pr = MAP == 1 ? phys_up(col) : MAP == 2 ? phys_in(col) : col;
        *(GAS v4u*)(WT + (size_t)pr * K + k0 + 8 * c) = o; }
    LDS_WAIT(); asm volatile("" ::: "memory");
}
__device__ __forceinline__ void ln_row(float* row, const float* g, const float* b, bf16* orow, int lane) {
    f32x4* xr = (f32x4*)row + lane;
    f32x4 v[4]; float s = 0.f;
#pragma unroll
    for (int j = 0; j < 4; ++j) { v[j] = xr[64 * j]; s += (v[j].x + v[j].y) + (v[j].z + v[j].w); }
    const float mean = wave_sum(s) * (1.f / D); float s2 = 0.f;
#pragma unroll
    for (int j = 0; j < 4; ++j) { v[j] = v[j] - mean; s2 += (v[j].x * v[j].x + v[j].y * v[j].y) + (v[j].z * v[j].z + v[j].w * v[j].w); }
    const float rstd = 1.f / sqrtf(wave_sum(s2) * (1.f / D) + LN_EPS);
#pragma unroll
    for (int j = 0; j < 4; ++j) {
        const f32x4 gg = ((const f32x4*)g)[lane + 64 * j], bb = ((const f32x4*)b)[lane + 64 * j];
        const f32x4 o = v[j] * rstd * gg + bb;
        xr[64 * j] = o;
        if (orow) { v2u w; w.x = cvt_pk_bf16(o.x, o.y); w.y = cvt_pk_bf16(o.z, o.w); ((v2u*)orow)[lane + 64 * j] = w; }
    }
}
__device__ __forceinline__ void sincos_d(double a, double& sn, double& cs) {
    const double q = __builtin_rint(a * 0.63661977236758134308);
    double r = __builtin_fma(-q, 1.57079632679489655800e+00, a); r = __builtin_fma(-q, 6.12323399573676603587e-17, r);
    const double z = r * r;
    double ps = 1.0 / 6227020800.0; ps = __builtin_fma(ps, -z, 1.0 / 39916800.0); ps = __builtin_fma(ps, -z, 1.0 / 362880.0); ps = __builtin_fma(ps, -z, 1.0 / 5040.0); ps = __builtin_fma(ps, -z, 1.0 / 120.0); ps = __builtin_fma(ps, -z, 1.0 / 6.0); ps = __builtin_fma(ps, -z, 1.0);
    double pc = 1.0 / 87178291200.0; pc = __builtin_fma(pc, -z, 1.0 / 479001600.0); pc = __builtin_fma(pc, -z, 1.0 / 3628800.0); pc = __builtin_fma(pc, -z, 1.0 / 40320.0); pc = __builtin_fma(pc, -z, 1.0 / 720.0); pc = __builtin_fma(pc, -z, 1.0 / 24.0); pc = __builtin_fma(pc, -z, 0.5); pc = __builtin_fma(pc, -z, 1.0);
    const double s0 = r * ps, c0 = pc;
    const int k = ((int)q) & 3;
    sn = (k == 0) ? s0 : (k == 1) ? c0 : (k == 2) ? -s0 : -c0;
    cs = (k == 0) ? c0 : (k == 1) ? -s0 : (k == 2) ? -c0 : s0;
}

struct Args { const float* in[19]; float* out; unsigned char* ws; };

__device__ __forceinline__ void p0_prologue(const Args& a, LAS unsigned char* lds, int gw, int NGW, int wave, int lane) {
    unsigned char* ws = a.ws;
    LAS float* scr = (LAS float*)(lds + wave * 16384);
    constexpr int I_UP = (D / 64) * (NUP / 32), I_DN = (FF / 64) * (D / 32), I_IN = (D / 64) * (NIN / 32), I_OUT = (D / 64) * (D / 32);
    constexpr int NITEMS = 2 * I_UP + 2 * I_DN + I_IN + I_OUT;
    for (int it = gw; it < NITEMS; it += NGW) {
        int r = it;
        if (r < I_UP) { p0_transpose_item<1>(a.in[1], D, NUP, (bf16*)(ws + WS_W1U), scr, r, lane); continue; } r -= I_UP;
        if (r < I_UP) { p0_transpose_item<1>(a.in[15], D, NUP, (bf16*)(ws + WS_W2U), scr, r, lane); continue; } r -= I_UP;
        if (r < I_DN) { p0_transpose_item<0>(a.in[2], FF, D, (bf16*)(ws + WS_W1D), scr, r, lane); continue; } r -= I_DN;
        if (r < I_DN) { p0_transpose_item<0>(a.in[16], FF, D, (bf16*)(ws + WS_W2D), scr, r, lane); continue; } r -= I_DN;
        if (r < I_IN) { p0_transpose_item<2>(a.in[5], D, NIN, (bf16*)(ws + WS_WIN), scr, r, lane); continue; } r -= I_IN;
        p0_transpose_item<0>(a.in[12], D, D, (bf16*)(ws + WS_WOUT), scr, r, lane);
    }
    bf16* XB = (bf16*)(ws + WS_XB);
    for (int m = gw; m < M; m += NGW) {
        const f32x4* xr = (const f32x4*)(a.in[0] + (size_t)m * D) + lane; v2u* o = (v2u*)(XB + (size_t)m * D) + lane;
#pragma unroll
        for (int j = 0; j < 4; ++j) { const f32x4 v = xr[64 * j]; v2u w; w.x = cvt_pk_bf16(v.x, v.y); w.y = cvt_pk_bf16(v.z, v.w); o[64 * j] = w; }
    }
    float* rope = (float*)(ws + WS_ROPE);
    for (int e = gw * 64 + lane; e < SEQ * 64; e += NGW * 64) {
        const int pos = e >> 6, i = e & 63;
        double pw = 1.0, bs = 0.86596432336006535; for (int bit = 0; bit < 6; ++bit) { if ((i >> bit) & 1) pw *= bs; bs *= bs; }
        const float inv = (float)pw;
        const float ang = (float)pos * inv;
        double sn, cs; sincos_d((double)ang, sn, cs);
        rope[e] = (float)cs; rope[SEQ * 64 + e] = (float)sn;
    }
    bf16* TR = (bf16*)(ws + WS_TRIL);
    for (int e = gw * 64 + lane; e < 4 * 128 * 128; e += NGW * 64) { const int t = (e >> 7) & 127, s = e & 127; TR[e] = (bf16)(cvt_pk_bf16(s <= t ? a.in[10][e] : 0.f, 0.f) & 0xffffu); }
}

__device__ __forceinline__ void gmlp_unit(const Args& a, LAS unsigned char* lds, int unit, int tid, int wave, int lane) {
    unsigned char* ws = a.ws;
    const int g = unit & 3, c = (unit >> 2) & 63, b = unit >> 8;
    const bf16* ZT = (const bf16*)(ws + WS_ZT) + (size_t)((b * 4 + g) * 128) * SEQ + c * 128;
    const bf16* TR = (const bf16*)(ws + WS_TRIL) + g * 128 * 128;
    const bf16* U = (const bf16*)(ws + WS_U); bf16* CAT = (bf16*)(ws + WS_CAT);
    LAS float* red = (LAS float*)lds;
    LAS float* stat = (LAS float*)(lds + 4096);
    const int fr = lane & 15, fq = lane >> 4;
    __syncthreads();
    { const int tt = tid & 127, part = tid >> 7; float s = 0.f, s2 = 0.f;
#pragma unroll 8
      for (int ch = part * 32; ch < part * 32 + 32; ++ch) { const float v = bf2f(ZT[(size_t)ch * SEQ + tt]); s += v; s2 += v * v; }
      red[(part * 128 + tt) * 2] = s; red[(part * 128 + tt) * 2 + 1] = s2; }
    __syncthreads();
    if (tid < 128) { float s = 0.f, s2 = 0.f;
#pragma unroll
      for (int p = 0; p < 4; ++p) { s += red[(p * 128 + tid) * 2]; s2 += red[(p * 128 + tid) * 2 + 1]; }
      const float mean = s * (1.f / 128.f); float var = s2 * (1.f / 128.f) - mean * mean; var = var < 0.f ? 0.f : var;
      stat[tid * 2] = mean; stat[tid * 2 + 1] = 1.f / sqrtf(var + LN_EPS); }
    __syncthreads();
    const int ch = 16 * wave + fr; const float lg = a.in[8][g * 128 + ch], lb = a.in[9][g * 128 + ch];
    bf16x8 af[4];
#pragma unroll
    for (int ks = 0; ks < 4; ++ks) {
        const v4u raw = *(const v4u*)(ZT + (size_t)ch * SEQ + 32 * ks + 8 * fq);
        const unsigned rw[4] = {raw.x, raw.y, raw.z, raw.w}; unsigned o[4];
#pragma unroll
        for (int p = 0; p < 4; ++p) { const int s0 = 32 * ks + 8 * fq + 2 * p;
            const float z0 = __uint_as_float(rw[p] << 16), z1 = __uint_as_float(rw[p] & 0xffff0000u);
            const float y0 = (z0 - stat[s0 * 2]) * stat[s0 * 2 + 1] * lg + lb, y1 = (z1 - stat[s0 * 2 + 2]) * stat[s0 * 2 + 3] * lg + lb;
            o[p] = cvt_pk_bf16(y0, y1); }
        const v4u ov = {o[0], o[1], o[2], o[3]}; af[ks] = __builtin_bit_cast(bf16x8, ov);
    }
#pragma unroll 1
    for (int rt = 0; rt < 8; ++rt) {
        f32x4 acc = {0.f, 0.f, 0.f, 0.f};
        const int t = 16 * rt + fr;
#pragma unroll
        for (int ks = 0; ks < 4; ++ks) if (32 * ks <= 16 * rt + 15) {
            const bf16x8 bw = *(const bf16x8*)(TR + t * 128 + 32 * ks + 8 * fq);
            acc = __builtin_amdgcn_mfma_f32_16x16x32_bf16(af[ks], bw, acc, 0, 0, 0);
        }
        const float bs = a.in[11][g * 128 + t];
        const size_t tok = (size_t)b * SEQ + c * 128 + t;
        const v2u uu = *(const v2u*)(U + tok * MW + g * 128 + 16 * wave + 4 * fq);
        const float u0 = __uint_as_float(uu.x << 16), u1 = __uint_as_float(uu.x & 0xffff0000u), u2 = __uint_as_float(uu.y << 16), u3 = __uint_as_float(uu.y & 0xffff0000u);
        v2u w; w.x = cvt_pk_bf16(u0 * (acc[0] + bs), u1 * (acc[1] + bs)); w.y = cvt_pk_bf16(u2 * (acc[2] + bs), u3 * (acc[3] + bs));
        *(v2u*)(CAT + tok * D + 512 + g * 128 + 16 * wave + 4 * fq) = w;
    }
}
__device__ __forceinline__ void r1_unit(const Args& a, int unit, int wave, int lane) {
    unsigned char* ws = a.ws;
    const int n = unit & 31, bh = unit >> 5, fr = lane & 15, fq = lane >> 4;
    const bf16* VT = (const bf16*)(ws + WS_VT) + (size_t)(bh * 128) * SEQ + n * RC;
    const bf16* KT = (const bf16*)(ws + WS_KTZ) + (size_t)(bh * 128) * SEQ + n * RC;
    f32x4 acc[8];
#pragma unroll
    for (int t = 0; t < 8; ++t) acc[t] = (f32x4){0.f, 0.f, 0.f, 0.f};
#pragma unroll 2
    for (int ks = 0; ks < 8; ++ks) {
        const bf16x8 av = *(const bf16x8*)(VT + (size_t)(16 * wave + fr) * SEQ + 32 * ks + 8 * fq);
#pragma unroll
        for (int t = 0; t < 8; ++t) { const bf16x8 bk = *(const bf16x8*)(KT + (size_t)(16 * t + fr) * SEQ + 32 * ks + 8 * fq);
            acc[t] = __builtin_amdgcn_mfma_f32_16x16x32_bf16(av, bk, acc[t], 0, 0, 0); }
    }
    float* KV = (float*)(ws + WS_KV) + (size_t)unit * 16384;
#pragma unroll
    for (int t = 0; t < 8; ++t)
#pragma unroll
        for (int r = 0; r < 4; ++r) KV[(16 * wave + 4 * fq + r) * 128 + 16 * t + fr] = acc[t][r];
}
__device__ __forceinline__ void r3_unit(const Args& a, int bhn, int p16, int lane) {
    unsigned char* ws = a.ws;
    const int n = bhn & 31, bh = bhn >> 5, b = bh >> 2, h = bh & 3, fr = lane & 15, fq = lane >> 4;
    const size_t tok0 = (size_t)b * SEQ + n * RC;
    const bf16* Qt = (const bf16*)(ws + WS_QT) + tok0 * MW + h * 128;
    const bf16* Kt = (const bf16*)(ws + WS_KT) + tok0 * MW + h * 128;
    const bf16* VT = (const bf16*)(ws + WS_VT) + (size_t)(bh * 128) * SEQ + n * RC;
    const bf16* ST = (const bf16*)(ws + WS_ST) + (size_t)bhn * 16384;
    bf16x8 qf[4];
#pragma unroll
    for (int ks = 0; ks < 4; ++ks) qf[ks] = *(const bf16x8*)(Qt + (size_t)(16 * p16 + fr) * MW + 32 * ks + 8 * fq);
    f32x4 o[8];
#pragma unroll
    for (int t = 0; t < 8; ++t) o[t] = (f32x4){0.f, 0.f, 0.f, 0.f};
    if (n > 0) {
#pragma unroll
        for (int t = 0; t < 8; ++t)
#pragma unroll
            for (int ks = 0; ks < 4; ++ks) { const bf16x8 as = *(const bf16x8*)(ST + (16 * t + fr) * 128 + 32 * ks + 8 * fq);
                o[t] = __builtin_amdgcn_mfma_f32_16x16x32_bf16(as, qf[ks], o[t], 0, 0, 0); }
        const float gm = h == 0 ? 0.96875f : h == 1 ? 0.984375f : h == 2 ? 0.9921875f : 0.99609375f;
#pragma unroll
        for (int t = 0; t < 8; ++t) o[t] = o[t] * gm;
    }
    const int nst = (p16 >> 1) + 1;
#pragma unroll 1
    for (int st = 0; st < nst; ++st) {
        const int k0 = 32 * st;
        f32x4 s0 = {0.f, 0.f, 0.f, 0.f}, s1 = {0.f, 0.f, 0.f, 0.f};
#pragma unroll
        for (int ks = 0; ks < 4; ++ks) {
            const bf16x8 a0 = *(const bf16x8*)(Kt + (size_t)(k0 + fr) * MW + 32 * ks + 8 * fq);
            const bf16x8 a1 = *(const bf16x8*)(Kt + (size_t)(k0 + 16 + fr) * MW + 32 * ks + 8 * fq);
            s0 = __builtin_amdgcn_mfma_f32_16x16x32_bf16(a0, qf[ks], s0, 0, 0, 0);
            s1 = __builtin_amdgcn_mfma_f32_16x16x32_bf16(a1, qf[ks], s1, 0, 0, 0);
        }
        if (st == nst - 1) { const int qa = 16 * p16 + fr;
#pragma unroll
            for (int r = 0; r < 4; ++r) { if (k0 + 4 * fq + r > qa) s0[r] = 0.f; if (k0 + 16 + 4 * fq + r > qa) s1[r] = 0.f; } }
        const v4u pv = {cvt_pk_bf16(s0[0], s0[1]), cvt_pk_bf16(s0[2], s0[3]), cvt_pk_bf16(s1[0], s1[1]), cvt_pk_bf16(s1[2], s1[3])};
        const bf16x8 pk = __builtin_bit_cast(bf16x8, pv);
#pragma unroll
        for (int t = 0; t < 8; ++t) {
            const bf16* vp = VT + (size_t)(16 * t + fr) * SEQ + k0 + 4 * fq;
            const v2u lo = *(const v2u*)vp, hi = *(const v2u*)(vp + 16);
            const v4u av = {lo.x, lo.y, hi.x, hi.y};
            o[t] = __builtin_amdgcn_mfma_f32_16x16x32_bf16(__builtin_bit_cast(bf16x8, av), pk, o[t], 0, 0, 0);
        }
    }
    float s = 0.f;
#pragma unroll
    for (int t = 0; t < 8; ++t) s += (o[t][0] + o[t][1]) + (o[t][2] + o[t][3]);
    s += __shfl_xor(s, 16); s += __shfl_xor(s, 32);
    const float mean = s * (1.f / 128.f); float q = 0.f;
#pragma unroll
    for (int t = 0; t < 8; ++t) { o[t] = o[t] - mean; q += (o[t][0] * o[t][0] + o[t][1] * o[t][1]) + (o[t][2] * o[t][2] + o[t][3] * o[t][3]); }
    q += __shfl_xor(q, 16); q += __shfl_xor(q, 32);
    const float rstd = 1.f / sqrtf(q * (1.f / 128.f) + LN_EPS);
    const size_t tok = tok0 + 16 * p16 + fr;
    const bf16* G = (const bf16*)(ws + WS_G) + tok * MW + h * 128; bf16* CAT = (bf16*)(ws + WS_CAT) + tok * D + h * 128;
#pragma unroll
    for (int t = 0; t < 8; ++t) {
        const int dv = 16 * t + 4 * fq;
        const f32x4 gg = *(const f32x4*)(a.in[6] + h * 128 + dv), gb = *(const f32x4*)(a.in[7] + h * 128 + dv);
        const v2u gt = *(const v2u*)(G + dv);
        const float g0 = __uint_as_float(gt.x << 16), g1 = __uint_as_float(gt.x & 0xffff0000u), g2 = __uint_as_float(gt.y << 16), g3 = __uint_as_float(gt.y & 0xffff0000u);
        const f32x4 y = o[t] * rstd * gg + gb;
        v2u w; w.x = cvt_pk_bf16(g0 * y[0], g1 * y[1]); w.y = cvt_pk_bf16(g2 * y[2], g3 * y[3]);
        *(v2u*)(CAT + dv) = w;
    }
}

__global__ void __launch_bounds__(NWAVES * 64, 2) mk_fwd(Args args) {
    extern __shared__ __attribute__((aligned(16))) unsigned char lds_raw[];
    cg::grid_group grid = cg::this_grid();
    LAS unsigned char* lds = (LAS unsigned char*)lds_raw;
    const int tid = threadIdx.x, lane = tid & 63, wave = __builtin_amdgcn_readfirstlane(tid >> 6);
    const int G = gridDim.x, bx = blockIdx.x;
    const int gw = bx * NWAVES + wave, NGW = G * NWAVES;
    unsigned char* ws = args.ws;
    bf16* XB = (bf16*)(ws + WS_XB); bf16* HB = (bf16*)(ws + WS_H); bf16* CAT = (bf16*)(ws + WS_CAT);
    float* out = args.out;
#define GRID_BAR() grid.sync()

    p0_prologue(args, lds, gw, NGW, wave, lane);
    GRID_BAR();
    { pg8::Gemm g{XB, (const bf16*)(ws + WS_W1U), M, NUP, D}; pg8::StaticOrder S; S.init(M, NUP, G, bx); pg8::EpiUp E{HB, FF};
      pg8::gemm_phase<pg8::EpiUp, pg8::StaticOrder, true, true>(lds, g, S, E); }
    GRID_BAR();
    { pg8::Gemm g{HB, (const bf16*)(ws + WS_W1D), M, D, FF}; pg8::StaticOrder S; S.init(M, D, G, bx); pg8::EpiRes E{args.in[0], out, ALPHA, 0.5f};
      pg8::gemm_phase<pg8::EpiRes, pg8::StaticOrder, true, true>(lds, g, S, E); }
    GRID_BAR();
    for (int m = gw; m < M; m += NGW) ln_row(out + (size_t)m * D, args.in[3], args.in[4], XB + (size_t)m * D, lane);
    GRID_BAR();
    { pg8::Gemm g{XB, (const bf16*)(ws + WS_WIN), M, NIN, D}; pg8::StaticOrder S; S.init(M, NIN, G, bx);
      pg8::EpiIn E{(bf16*)(ws + WS_QT), (bf16*)(ws + WS_KT), (bf16*)(ws + WS_KTZ), (bf16*)(ws + WS_VT), (bf16*)(ws + WS_G), (bf16*)(ws + WS_U), (bf16*)(ws + WS_ZT), (const float*)(ws + WS_ROPE)};
      pg8::gemm_phase<pg8::EpiIn, pg8::StaticOrder, true, true>(lds, g, S, E); }
    GRID_BAR();
    for (int u = bx; u < BATCH * 64 * 4; u += G) gmlp_unit(args, lds, u, tid, wave, lane);
    for (int u = bx; u < 32 * NCH; u += G) r1_unit(args, u, wave, lane);
    GRID_BAR();
    { const float* KV = (const float*)(ws + WS_KV); bf16* ST = (bf16*)(ws + WS_ST);
      for (int e = bx * (NWAVES * 64) + tid; e < 32 * 4096; e += G * NWAVES * 64) {
        const int bh = e >> 12, off = (e & 4095) * 4, h = bh & 3;
        const float gc = h == 0 ? 0.0002952562990352836f : h == 1 ? 0.017746279621051256f : h == 2 ? 0.13427659965015967f : 0.36715975489153624f;
        f32x4 s = {0.f, 0.f, 0.f, 0.f};
#pragma unroll 4
        for (int n = 0; n < NCH - 1; ++n) {
            const f32x4 kv = *(const f32x4*)(KV + (size_t)(bh * NCH + n) * 16384 + off);
            s = s * gc + kv;
            v2u w; w.x = cvt_pk_bf16(s.x, s.y); w.y = cvt_pk_bf16(s.z, s.w);
            *(v2u*)(ST + (size_t)(bh * NCH + n + 1) * 16384 + off) = w;
        } } }
    GRID_BAR();
    for (int k = 0; k < 8; ++k) {
        const int g2 = gw, q = g2 & 15, p16 = (k & 1) ? 15 - q : q, bhn = (g2 >> 4) + 128 * k;
        if (NGW == 2048) r3_unit(args, bhn, p16, lane);
    }
    if (NGW != 2048) { for (int u = gw; u < 16384; u += NGW) r3_unit(args, u >> 4, u & 15, lane); }
    GRID_BAR();
    { pg8::Gemm g{CAT, (const bf16*)(ws + WS_WOUT), M, D, D}; pg8::StaticOrder S; S.init(M, D, G, bx); pg8::EpiRes E{out, out, ALPHA, 1.0f};
      pg8::gemm_phase<pg8::EpiRes, pg8::StaticOrder, true, true>(lds, g, S, E); }
    GRID_BAR();
    for (int m = gw; m < M; m += NGW) ln_row(out + (size_t)m * D, args.in[13], args.in[14], XB + (size_t)m * D, lane);
    GRID_BAR();
    { pg8::Gemm g{XB, (const bf16*)(ws + WS_W2U), M, NUP, D}; pg8::StaticOrder S; S.init(M, NUP, G, bx); pg8::EpiUp E{HB, FF};
      pg8::gemm_phase<pg8::EpiUp, pg8::StaticOrder, true, true>(lds, g, S, E); }
    GRID_BAR();
    { pg8::Gemm g{HB, (const bf16*)(ws + WS_W2D), M, D, FF}; pg8::StaticOrder S; S.init(M, D, G, bx); pg8::EpiRes E{out, out, ALPHA, 0.5f};
      pg8::gemm_phase<pg8::EpiRes, pg8::StaticOrder, true, true>(lds, g, S, E); }
    GRID_BAR();
    for (int m = gw; m < M; m += NGW) ln_row(out + (size_t)m * D, args.in[17], args.in[18], nullptr, lane);
}

extern "C" void kernel_launch(void* const* d_in, const int* in_sizes, int n_in, void* d_out, int out_size, void* d_ws, size_t ws_size, hipStream_t stream) {
    static int grid = 0;
    if (grid == 0) {
        if (n_in != 19 || out_size != M * D || ws_size < WS_END) { fprintf(stderr, "kernel_launch: unexpected shapes n_in %d out %d ws %zu\n", n_in, out_size, ws_size); grid = -1; return; }
        int dev = 0, cus = 0, per_cu = 0;
        (void)hipGetDevice(&dev); (void)hipDeviceGetAttribute(&cus, hipDeviceAttributeMultiprocessorCount, dev);
        if (hipFuncSetAttribute((const void*)mk_fwd, hipFuncAttributeMaxDynamicSharedMemorySize, LDS_BYTES) != hipSuccess) { fprintf(stderr, "kernel_launch: hipFuncSetAttribute failed\n"); grid = -1; return; }
        (void)hipOccupancyMaxActiveBlocksPerMultiprocessor(&per_cu, (const void*)mk_fwd, NWAVES * 64, LDS_BYTES);
        if (per_cu < 1) { fprintf(stderr, "kernel_launch: occupancy query says %d\n", per_cu); per_cu = 1; }
        (void)hipGetLastError();
        grid = cus;
    }
    if (grid < 0) return;
    Args a{};
    for (int i = 0; i < 19; ++i) a.in[i] = (const float*)d_in[i];
    a.out = (float*)d_out; a.ws = (unsigned char*)d_ws;
    void* kargs[] = {&a};
    hipError_t e = hipLaunchCooperativeKernel((const void*)mk_fwd, dim3(grid), dim3(NWAVES * 64), kargs, LDS_BYTES, stream);
    if (e != hipSuccess) fprintf(stderr, "cooperative launch failed: %s (grid %d)\n", hipGetErrorString(e), grid);
}
```

```cpp
#include <hip/hip_runtime.h>
#include <hip/hip_cooperative_groups.h>
#include <cstdio>
#include <cstdint>
namespace cg = cooperative_groups;
namespace pg8 {
#define PG8_LAS __attribute__((address_space(3)))
typedef unsigned short bf16_t;
typedef short bf16x8 __attribute__((ext_vector_type(8)));
typedef float f32x4 __attribute__((ext_vector_type(4)));
typedef unsigned u32x4 __attribute__((ext_vector_type(4)));
constexpr int BM = 256, BK = 64, HALF = 128, HTB = HALF * BK * 2  , STAGE_BYTES = 8 * HTB, NXCD = 8, WGM = 8;

__host__ __device__ __forceinline__ int lds_byte(int r, int c) { const int st = (r >> 4) * 2 + (c >> 5), rr = r & 15, cc = c & 31, ob = rr * 64 + cc * 2; return st * 1024 + (ob ^ (((ob >> 9) & 1) << 5)); }
__host__ __device__ __forceinline__ void stage_rc(int b, int& R, int& C) { const int st = b / 1024, sb = b % 1024, swz = sb ^ (((sb >> 9) & 1) << 5); R = (st >> 1) * 16 + swz / 64; C = (st & 1) * 32 + (swz % 64) / 2; }
__host__ __device__ __forceinline__ int perm32(int rho) { const int n = rho >> 4, i = rho & 15; return 8 * (i >> 2) + 4 * n + (i & 3); }

struct Unit { int pm, pn; };
struct Gemm { const bf16_t* A; const bf16_t* Bt; int M, N, K; };

struct StaticOrder {
    int nM, nN, nwg, G, c;
    __host__ __device__ void init(int M, int N, int G_, int c_) { nM = M / BM; nN = N / BM; nwg = nM * nN; G = G_; c = c_; }
    __host__ __device__ bool next(int i, Unit& u) const {
        const long L = (long)i * G + c; if (L >= nwg) return false;
        int wgid = (int)L; { const int q = nwg / NXCD, r = nwg % NXCD, xcd = wgid % NXCD, off = wgid / NXCD; wgid = (xcd < r ? xcd * (q + 1) : r * (q + 1) + (xcd - r) * q) + off; }
        const int nig = WGM * nN, gid = wgid / nig, fm = gid * WGM, gsz = (nM - fm) < WGM ? (nM - fm) : WGM;
        u.pm = fm + ((wgid % nig) % gsz); u.pn = (wgid % nig) / gsz; return true;
    }
    __device__ __forceinline__ void a_ready(const Unit&) const {}
    __device__ __forceinline__ void done(const Unit&) const {}
};
__device__ __forceinline__ unsigned cvt_pk_bf16(float lo, float hi) { unsigned r; asm volatile("v_cvt_pk_bf16_f32 %0, %1, %2" : "=v"(r) : "v"(lo), "v"(hi)); return r; }
typedef float f32x2 __attribute__((ext_vector_type(2)));
__device__ __forceinline__ f32x2 gelu_pk(f32x2 v) {
    const f32x2 av = __builtin_elementwise_abs(v), d = av * 0.2316418882f + 1.0f;
    f32x2 t; t.x = __builtin_amdgcn_rcpf(d.x); t.y = __builtin_amdgcn_rcpf(d.y);
    f32x2 q = t * 0.5307027145f + (-0.7265760135f); q = q * t + 0.7107068705f; q = q * t + (-0.142248368f); q = q * t + 0.127414796f; q = q * t;
    const f32x2 s = (v * v) * (-0.72134752044f);
    f32x2 e; e.x = __builtin_amdgcn_exp2f(s.x); e.y = __builtin_amdgcn_exp2f(s.y);
    const f32x2 m = v * (q * e), r = v - m;
    f32x2 o; o.x = v.x < 0.f ? m.x : r.x; o.y = v.y < 0.f ? m.y : r.y; return o;
}
__device__ __forceinline__ float fast_silu(float g) { return g * __builtin_amdgcn_rcpf(1.0f + __builtin_amdgcn_exp2f(-1.4426950408889634f * g)); }
__device__ __forceinline__ float bf2f(unsigned short b) { return __uint_as_float(((unsigned)b) << 16); }
typedef unsigned u32x2 __attribute__((ext_vector_type(2)));

struct EpiUp {
    static constexpr bool PERM = false, AFTER_DRAIN = false;
    bf16_t* H; int ldh;
    __device__ __forceinline__ void operator()(const f32x4 (&acc)[2][2][4][2], const Unit& u, int wr, int wc, int fr, int fq) const {
        const int row0 = u.pm * BM + wr * 64 + fr, col0 = u.pn * 128 + wc * 32 + 8 * fq;
#pragma unroll
        for (int ai = 0; ai < 2; ++ai)
#pragma unroll
            for (int m = 0; m < 4; ++m) {
                bf16_t* p = H + (size_t)(row0 + ai * HALF + m * 16) * ldh + col0;
                float h[8];
#pragma unroll
                for (int n = 0; n < 2; ++n)
#pragma unroll
                    for (int j = 0; j < 4; ++j) h[n * 4 + j] = fast_silu(acc[ai][0][m][n][j]) * acc[ai][1][m][n][j];
                u32x4 w; w.x = cvt_pk_bf16(h[0], h[1]); w.y = cvt_pk_bf16(h[2], h[3]); w.z = cvt_pk_bf16(h[4], h[5]); w.w = cvt_pk_bf16(h[6], h[7]);
                *(u32x4*)p = w;
            }
    }
};
struct EpiRes {
    static constexpr bool PERM = false, AFTER_DRAIN = false;
    const float* res; float* out; float alpha, scale;
    __device__ __forceinline__ void operator()(const f32x4 (&acc)[2][2][4][2], const Unit& u, int wr, int wc, int fr, int fq) const {
        const int row0 = u.pm * BM + wr * 64 + fr, col0 = u.pn * BM + wc * 32 + 4 * fq;
#pragma unroll
        for (int ai = 0; ai < 2; ++ai)
#pragma unroll
            for (int m = 0; m < 4; ++m) {
                const size_t off = (size_t)(row0 + ai * HALF + m * 16) * 1024 + col0;
                f32x4 r[2][2];
#pragma unroll
                for (int bj = 0; bj < 2; ++bj)
#pragma unroll
                    for (int n = 0; n < 2; ++n) r[bj][n] = *(const f32x4*)(res + off + bj * HALF + n * 16);
#pragma unroll
                for (int bj = 0; bj < 2; ++bj)
#pragma unroll
                    for (int n = 0; n < 2; ++n) *(f32x4*)(out + off + bj * HALF + n * 16) = r[bj][n] * alpha + acc[ai][bj][m][n] * scale;
            }
    }
};
struct EpiIn {
    static constexpr bool PERM = false, AFTER_DRAIN = false;
    bf16_t *Qt, *Kt, *KTz, *VT, *G, *U, *ZT; const float* rope;
    __device__ __forceinline__ void operator()(const f32x4 (&acc)[2][2][4][2], const Unit& u, int wr, int wc, int fr, int fq) const {
        const int sec = u.pn >> 1, half = u.pn & 1;
        const int rowb = u.pm * BM + wr * 64 + fr;
        if (sec <= 1) {
#pragma unroll
            for (int ai = 0; ai < 2; ++ai)
#pragma unroll
                for (int m = 0; m < 4; ++m) {
                    const int row = rowb + ai * HALF + m * 16, ip = row & 255, pos = row & 8191, bb = row >> 13;
                    const int i0 = 16 * wc + 4 * fq;
                    const f32x4 c4 = *(const f32x4*)(rope + (size_t)pos * 64 + i0), s4 = *(const f32x4*)(rope + (size_t)(8192 + pos) * 64 + i0);
#pragma unroll
                    for (int bj = 0; bj < 2; ++bj) {
                        const int head = half * 2 + bj;
                        const float lg = head == 0 ? -0.04580368961312479f : head == 1 ? -0.02272007650008353f : head == 2 ? -0.011315313227834146f : -0.005646563141142063f;
                        const f32x4 x1 = acc[ai][bj][m][0], x2 = acc[ai][bj][m][1];
                        const f32x4 o1 = x1 * c4 - x2 * s4, o2 = x1 * s4 + x2 * c4;
                        if (sec == 0) {
                            const float f = __builtin_amdgcn_exp2f((float)ip * lg);
                            bf16_t* p = Qt + (size_t)row * 512 + head * 128 + i0;
                            u32x2 w1, w2; w1.x = cvt_pk_bf16(o1[0] * f, o1[1] * f); w1.y = cvt_pk_bf16(o1[2] * f, o1[3] * f);
                            w2.x = cvt_pk_bf16(o2[0] * f, o2[1] * f); w2.y = cvt_pk_bf16(o2[2] * f, o2[3] * f);
                            *(u32x2*)p = w1; *(u32x2*)(p + 64) = w2;
                        } else {
                            const float f1 = 0.08838834764831845f * __builtin_amdgcn_exp2f(-(float)ip * lg);
                            const float f2 = 0.08838834764831845f * __builtin_amdgcn_exp2f((float)(255 - ip) * lg);
                            bf16_t* p = Kt + (size_t)row * 512 + head * 128 + i0;
                            u32x2 w1, w2; w1.x = cvt_pk_bf16(o1[0] * f1, o1[1] * f1); w1.y = cvt_pk_bf16(o1[2] * f1, o1[3] * f1);
                            w2.x = cvt_pk_bf16(o2[0] * f1, o2[1] * f1); w2.y = cvt_pk_bf16(o2[2] * f1, o2[3] * f1);
                            *(u32x2*)p = w1; *(u32x2*)(p + 64) = w2;
                            bf16_t* t = KTz + ((size_t)((bb * 4 + head) * 128 + i0)) * 8192 + pos;
#pragma unroll
                            for (int j = 0; j < 4; ++j) {
                                t[(size_t)j * 8192] = (bf16_t)(cvt_pk_bf16(o1[j] * f2, 0.f) & 0xffffu);
                                t[(size_t)(64 + j) * 8192] = (bf16_t)(cvt_pk_bf16(o2[j] * f2, 0.f) & 0xffffu);
                            }
                        }
                    }
                }
        } else if (sec == 2 || sec == 5) {
            bf16_t* T = sec == 2 ? VT : ZT;
#pragma unroll
            for (int ai = 0; ai < 2; ++ai)
#pragma unroll
                for (int m = 0; m < 4; ++m) {
                    const int row = rowb + ai * HALF + m * 16, pos = row & 8191, bb = row >> 13;
#pragma unroll
                    for (int bj = 0; bj < 2; ++bj) {
                        const int grp = half * 2 + bj;
#pragma unroll
                        for (int n = 0; n < 2; ++n) {
                            f32x4 v = acc[ai][bj][m][n];
                            int ch;
                            if (sec == 5) { f32x2 a = gelu_pk((f32x2){v[0], v[1]}), b = gelu_pk((f32x2){v[2], v[3]}); v = (f32x4){a.x, a.y, b.x, b.y}; ch = wc * 32 + 8 * fq + 4 * n; }
                            else ch = wc * 32 + 16 * n + 4 * fq;
                            bf16_t* t = T + ((size_t)((bb * 4 + grp) * 128 + ch)) * 8192 + pos;
#pragma unroll
                            for (int j = 0; j < 4; ++j) t[(size_t)j * 8192] = (bf16_t)(cvt_pk_bf16(v[j], 0.f) & 0xffffu);
                        }
                    }
                }
        } else {
            bf16_t* O = sec == 3 ? G : U;
#pragma unroll
            for (int ai = 0; ai < 2; ++ai)
#pragma unroll
                for (int m = 0; m < 4; ++m) {
                    const int row = rowb + ai * HALF + m * 16;
#pragma unroll
                    for (int bj = 0; bj < 2; ++bj) {
                        f32x4 v0 = acc[ai][bj][m][0], v1 = acc[ai][bj][m][1];
                        if (sec == 3) {
#pragma unroll
                            for (int j = 0; j < 4; ++j) { v0[j] = fast_silu(v0[j]); v1[j] = fast_silu(v1[j]); }
                        } else {
                            f32x2 a = gelu_pk((f32x2){v0[0], v0[1]}), b = gelu_pk((f32x2){v0[2], v0[3]}), c = gelu_pk((f32x2){v1[0], v1[1]}), d = gelu_pk((f32x2){v1[2], v1[3]});
                            v0 = (f32x4){a.x, a.y, b.x, b.y}; v1 = (f32x4){c.x, c.y, d.x, d.y};
                        }
                        u32x4 w; w.x = cvt_pk_bf16(v0[0], v0[1]); w.y = cvt_pk_bf16(v0[2], v0[3]); w.z = cvt_pk_bf16(v1[0], v1[1]); w.w = cvt_pk_bf16(v1[2], v1[3]);
                        *(u32x4*)(O + (size_t)row * 512 + half * 256 + bj * 128 + wc * 32 + 8 * fq) = w;
                    }
                }
        }
    }
};
template <class Epi, class Sched, bool ALIGN_EPI = false, bool SP2 = false>
__device__ __forceinline__ void gemm_phase(PG8_LAS unsigned char* lds, const Gemm g, const Sched& S, const Epi& E) {
    const int tid = threadIdx.x, wid = __builtin_amdgcn_readfirstlane(tid >> 6), lane = tid & 63, wr = wid >> 2, wc = wid & 3, fr = lane & 15, fq = lane >> 4;
    const int K = g.K, nt = K / BK;
    unsigned voffA[2], voffB[2];
#pragma unroll
    for (int i = 0; i < 2; ++i) { int R, C; stage_rc(tid * 16 + i * 8192, R, C); const int Rb = Epi::PERM ? ((R & ~31) + perm32(R & 31)) : R;
        voffA[i] = (unsigned)(R * K + C) * 2u; voffB[i] = (unsigned)(Rb * K + C) * 2u; }
    const size_t kstep = (size_t)(BK * 2);
    const size_t hstep = (size_t)HALF * K * 2;
    const size_t tstep = 2 * hstep;
    const unsigned ldsw = (unsigned)wid * 1024u;
    const int aoff = lds_byte(wr * 64 + fr, fq * 8), boff = lds_byte(wc * 32 + fr, fq * 8);
#define PG8_SA(b, h) (((b) * 2 + (h)) * HTB)
#define PG8_SB(b, h) ((4 + (b) * 2 + (h)) * HTB)
#define PG8_STAGE(bufoff, gbase, voff) do { _Pragma("unroll") for (int _i = 0; _i < 2; ++_i) \
        __builtin_amdgcn_global_load_lds((const unsigned*)((const char*)(gbase) + (voff)[_i]), (PG8_LAS unsigned*)(lds + (bufoff) + ldsw + _i * 8192), 16, 0, 0); } while (0)
#define PG8_LDA(dst, b, h) do { _Pragma("unroll") for (int m = 0; m < 4; ++m) _Pragma("unroll") for (int k = 0; k < 2; ++k) dst[m][k] = *(const PG8_LAS bf16x8*)(lds + PG8_SA(b, h) + aoff + m * 2048 + k * 1024); } while (0)
#define PG8_LDB(dst, b, h) do { _Pragma("unroll") for (int n = 0; n < 2; ++n) _Pragma("unroll") for (int k = 0; k < 2; ++k) dst[n][k] = *(const PG8_LAS bf16x8*)(lds + PG8_SB(b, h) + boff + n * 2048 + k * 1024); } while (0)
#define PG8_MMA(ai, bj, At, Bt) do { __builtin_amdgcn_s_setprio(1); _Pragma("unroll") for (int m = 0; m < 4; ++m) _Pragma("unroll") for (int n = 0; n < 2; ++n) _Pragma("unroll") for (int k = 0; k < 2; ++k) \
        acc[ai][bj][m][n] = __builtin_amdgcn_mfma_f32_16x16x32_bf16(Bt[n][k], At[m][k], acc[ai][bj][m][n], 0, 0, 0); __builtin_amdgcn_s_setprio(0); } while (0)
#define PG8_WAIT_V(n) asm volatile("s_waitcnt vmcnt(" #n ")" ::: "memory")
#define PG8_WAIT_L(n) asm volatile("s_waitcnt lgkmcnt(" #n ")" ::: "memory")
#define PG8_BAR __builtin_amdgcn_s_barrier()
#define PG8_SCHED __builtin_amdgcn_sched_barrier(0)
    Unit cur, nxt; int ui = 0;
    if (!S.next(0, cur)) return;
    f32x4 acc[2][2][4][2];
#pragma unroll
    for (int a = 0; a < 2; ++a)
#pragma unroll
        for (int b = 0; b < 2; ++b)
#pragma unroll
            for (int m = 0; m < 4; ++m)
#pragma unroll
                for (int n = 0; n < 2; ++n) acc[a][b][m][n] = (f32x4){0.f, 0.f, 0.f, 0.f};
    bf16x8 At[4][2], B0[2][2], B1[2][2];
    const char* cA = (const char*)g.A + (size_t)cur.pm * tstep; const char* cB = (const char*)g.Bt + (size_t)cur.pn * tstep;
    S.a_ready(cur);
    if constexpr (SP2) {
        PG8_STAGE(PG8_SB(0, 0), cB, voffB); PG8_STAGE(PG8_SB(0, 1), cB + hstep, voffB); PG8_STAGE(PG8_SA(0, 0), cA, voffA); PG8_STAGE(PG8_SA(0, 1), cA + hstep, voffA);
        if (wr == 1) PG8_BAR;
        PG8_WAIT_V(2); PG8_BAR;
        PG8_STAGE(PG8_SB(1, 0), cB + kstep, voffB); PG8_STAGE(PG8_SA(1, 0), cA + kstep, voffA); PG8_STAGE(PG8_SB(1, 1), cB + hstep + kstep, voffB);
        PG8_WAIT_V(6); PG8_BAR;
    } else {
        PG8_STAGE(PG8_SB(0, 0), cB, voffB); PG8_STAGE(PG8_SA(0, 0), cA, voffA); PG8_STAGE(PG8_SB(0, 1), cB + hstep, voffB); PG8_STAGE(PG8_SA(0, 1), cA + hstep, voffA);
        if (wr == 1) PG8_BAR;
        PG8_WAIT_V(4); PG8_BAR;
        PG8_STAGE(PG8_SB(1, 0), cB + kstep, voffB); PG8_STAGE(PG8_SA(1, 0), cA + kstep, voffA); PG8_STAGE(PG8_SB(1, 1), cB + hstep + kstep, voffB);
        PG8_WAIT_V(6); PG8_BAR;
    }
    for (;;) {
        const bool has_next = S.next(ui + 1, nxt);
        const char* nA = has_next ? (const char*)g.A + (size_t)nxt.pm * tstep : cA; const char* nB = has_next ? (const char*)g.Bt + (size_t)nxt.pn * tstep : cB;
        for (int t = 0; t < nt; t += 2) {
            const bool last = (t == nt - 2);
            const char* a1 = cA + (size_t)(t + 1) * kstep;
            const char* a2 = last ? nA : cA + (size_t)(t + 2) * kstep; const char* b2 = last ? nB : cB + (size_t)(t + 2) * kstep;
            const char* a3 = a2 + kstep; const char* b3 = b2 + kstep;
            if (last && has_next) S.a_ready(nxt);
            if constexpr (SP2) {
            PG8_LDB(B0, 0, 0); PG8_LDB(B1, 0, 1); PG8_SCHED; PG8_LDA(At, 0, 0); PG8_STAGE(PG8_SA(1, 1), a1 + hstep, voffA);
            PG8_WAIT_V(8); PG8_WAIT_L(0); PG8_BAR; PG8_MMA(0, 0, At, B0); PG8_MMA(0, 1, At, B1); PG8_BAR; PG8_SCHED;
            PG8_LDA(At, 0, 1); PG8_STAGE(PG8_SB(0, 0), b2, voffB); PG8_STAGE(PG8_SB(0, 1), b2 + hstep, voffB); PG8_STAGE(PG8_SA(0, 0), a2, voffA);
            PG8_WAIT_V(8); PG8_WAIT_L(0); PG8_BAR; PG8_MMA(1, 0, At, B0); PG8_MMA(1, 1, At, B1); PG8_BAR; PG8_SCHED;
            PG8_LDB(B0, 1, 0); PG8_LDB(B1, 1, 1); PG8_SCHED; PG8_LDA(At, 1, 0); PG8_STAGE(PG8_SA(0, 1), a2 + hstep, voffA);
            PG8_WAIT_V(8); PG8_WAIT_L(0); PG8_BAR; PG8_MMA(0, 0, At, B0); PG8_MMA(0, 1, At, B1); PG8_BAR; PG8_SCHED;
            PG8_LDA(At, 1, 1); PG8_STAGE(PG8_SB(1, 0), b3, voffB); PG8_STAGE(PG8_SB(1, 1), b3 + hstep, voffB); PG8_STAGE(PG8_SA(1, 0), a3, voffA);
            PG8_WAIT_V(8); PG8_WAIT_L(0); PG8_BAR; PG8_MMA(1, 0, At, B0); PG8_MMA(1, 1, At, B1); PG8_BAR; PG8_SCHED;
            } else {
            PG8_LDB(B0, 0, 0); PG8_SCHED; PG8_LDA(At, 0, 0); PG8_STAGE(PG8_SA(1, 1), a1 + hstep, voffA);
            PG8_WAIT_L(8); PG8_BAR; PG8_WAIT_L(0); PG8_MMA(0, 0, At, B0); PG8_BAR; PG8_SCHED;
            PG8_LDB(B1, 0, 1); PG8_STAGE(PG8_SB(0, 0), b2, voffB);
            PG8_BAR; PG8_WAIT_L(0); PG8_MMA(0, 1, At, B1); PG8_BAR;
            PG8_LDA(At, 0, 1); PG8_STAGE(PG8_SA(0, 0), a2, voffA);
            PG8_BAR; PG8_WAIT_L(0); PG8_MMA(1, 0, At, B0); PG8_BAR; PG8_SCHED;
            PG8_STAGE(PG8_SB(0, 1), b2 + hstep, voffB);
            PG8_WAIT_V(6); PG8_BAR; PG8_MMA(1, 1, At, B1); PG8_BAR;
            PG8_LDB(B0, 1, 0); PG8_SCHED; PG8_LDA(At, 1, 0); PG8_STAGE(PG8_SA(0, 1), a2 + hstep, voffA);
            PG8_WAIT_L(8); PG8_BAR; PG8_WAIT_L(0); PG8_MMA(0, 0, At, B0); PG8_BAR; PG8_SCHED;
            PG8_LDB(B1, 1, 1); PG8_STAGE(PG8_SB(1, 0), b3, voffB);
            PG8_BAR; PG8_WAIT_L(0); PG8_MMA(0, 1, At, B1); PG8_BAR;
            PG8_LDA(At, 1, 1); PG8_STAGE(PG8_SA(1, 0), a3, voffA);
            PG8_BAR; PG8_WAIT_L(0); PG8_MMA(1, 0, At, B0); PG8_BAR; PG8_SCHED;
            PG8_STAGE(PG8_SB(1, 1), b3 + hstep, voffB);
            PG8_WAIT_V(6); PG8_BAR; PG8_MMA(1, 1, At, B1); PG8_BAR;
            }
        }
        if constexpr (ALIGN_EPI) { if (wr == 0) PG8_BAR; }
        if constexpr (!Epi::AFTER_DRAIN) { E(acc, cur, wr, wc, fr, fq); S.done(cur); }
        if (!has_next) break;
#pragma unroll
        for (int a = 0; a < 2; ++a)
#pragma unroll
            for (int b = 0; b < 2; ++b)
#pragma unroll
                for (int m = 0; m < 4; ++m)
#pragma unroll
                    for (int n = 0; n < 2; ++n) acc[a][b][m][n] = (f32x4){0.f, 0.f, 0.f, 0.f};
        cur = nxt; cA = nA; cB = nB; ++ui;
        if constexpr (ALIGN_EPI) { if (wr == 1) PG8_BAR; }
    }
    PG8_WAIT_V(0);
    if constexpr (!ALIGN_EPI) { if (wr == 0) PG8_BAR; }
    PG8_BAR;
    if constexpr (Epi::AFTER_DRAIN) { E.fused(acc, cur, wr, wc, fr, fq, lds, wid, lane); S.done(cur); }
#undef PG8_SA
#undef PG8_SB
#undef PG8_STAGE
#undef PG8_LDA
#undef PG8_LDB
#undef PG8_MMA
#undef PG8_WAIT_V
#undef PG8_WAIT_L
#undef PG8_BAR
#undef PG8_SCHED
}
}
constexpr int NWAVES = 8;
constexpr int BATCH = 8, SEQ = 8192, D = 1024, FF = 2816, NUP = 2 * FF, NIN = 3072, MW = 512;
constexpr int M = BATCH * SEQ;
constexpr float LN_EPS = 1e-5f, ALPHA = 1.189207115002721f;
constexpr int RC = 256, NCH = SEQ / RC;
constexpr size_t MiB = 1u << 20;
constexpr size_t WS_W1U = 1 * MiB, WS_W1D = 12 * MiB, WS_WIN = 18 * MiB, WS_WOUT = 24 * MiB, WS_W2U = 26 * MiB, WS_W2D = 37 * MiB;
constexpr size_t WS_TRIL = 43 * MiB, WS_ROPE = 44 * MiB;
constexpr size_t WS_XB = 64 * MiB;
constexpr size_t WS_R = 192 * MiB;
constexpr size_t WS_H = WS_R;
constexpr size_t WS_QT = WS_R, WS_KT = WS_R + 64 * MiB, WS_KTZ = WS_R + 128 * MiB, WS_VT = WS_R + 192 * MiB, WS_G = WS_R + 256 * MiB, WS_U = WS_R + 320 * MiB, WS_ZT = WS_R + 384 * MiB;
constexpr size_t WS_KV = 640 * MiB, WS_ST = 704 * MiB;
constexpr size_t WS_CAT = 768 * MiB, WS_END = 896 * MiB;
static_assert(WS_H + (size_t)M * FF * 2 <= WS_KV && WS_ZT + 64 * MiB <= WS_KV, "ws map");
constexpr int LDS_BYTES = 147456;

#define GAS __attribute__((address_space(1)))
#define LAS __attribute__((address_space(3)))
typedef unsigned short bf16;
typedef unsigned v4u __attribute__((ext_vector_type(4)));
typedef unsigned v2u __attribute__((ext_vector_type(2)));
typedef float f32x4 __attribute__((ext_vector_type(4)));
typedef short bf16x8 __attribute__((ext_vector_type(8)));
using pg8::cvt_pk_bf16; using pg8::bf2f; using pg8::fast_silu;
#define LDS_WAIT() asm volatile("s_waitcnt lgkmcnt(0)" ::: "memory")
#define XB_TMO      128
#define XB_XCNT(j)  (256  + 64 * (j))
#define XB_XSUB(j)  (1280 + 64 * (j))
#define XB_XGEN(j)  (2304 + 64 * (j))
#define XB_TOP      3328
#define XB_TOPGEN   3392
#define XCD_BAR_WORDS 3456
#define XB_SPIN_CAP (1u << 22)

__device__ __forceinline__ unsigned xb_ld(unsigned* p)              { return __hip_atomic_load(p, __ATOMIC_RELAXED, __HIP_MEMORY_SCOPE_AGENT); }
__device__ __forceinline__ unsigned xb_add(unsigned* p, unsigned v) { return __hip_atomic_fetch_add(p, v, __ATOMIC_RELAXED, __HIP_MEMORY_SCOPE_AGENT); }
__device__ __forceinline__ unsigned xb_xcc_id() { return (unsigned)__builtin_amdgcn_s_getreg((3 << 11) | 20) & 0xFu; }
#define XB_SPIN(cond, bar) do { unsigned _sp = 0; while (cond) { __builtin_amdgcn_s_sleep(1); \
    if ((++_sp & 255u) == 0u) { if (xb_ld(&(bar)[XB_TMO])) break; if (_sp > XB_SPIN_CAP) { atomicAdd(&(bar)[XB_TMO], 1u); break; } } } } while (0)

struct XcdBarrier {
    unsigned* bar; unsigned x;
    volatile LAS unsigned* st;
};

__device__ __forceinline__ XcdBarrier xcd_barrier_post(unsigned* bar, volatile LAS unsigned* st) {
    XcdBarrier b; b.bar = bar; b.x = xb_xcc_id(); b.st = st;
    if (threadIdx.x == 0) (void)xb_add(&bar[XB_XCNT(b.x)], 1u);
    return b;
}
__device__ __forceinline__ void xcd_barrier_complete(unsigned* bar, unsigned x, unsigned& nloc, unsigned& nx) {
    const unsigned G = gridDim.x * gridDim.y * gridDim.z;
    unsigned sum, cnt, mine, sp = 0u;
    for (;;) {
        sum = 0u; cnt = 0u; mine = 0u;
#pragma unroll
        for (unsigned j = 0; j < 16; ++j) { const unsigned c = xb_ld(&bar[XB_XCNT(j)]); sum += c; cnt += (c > 0u) ? 1u : 0u; mine = (j == x) ? c : mine; }
        if (sum == G) break;
        __builtin_amdgcn_s_sleep(1);
        if ((++sp & 255u) == 0u) { if (xb_ld(&bar[XB_TMO])) break; if (sp > XB_SPIN_CAP) { atomicAdd(&bar[XB_TMO], 1u); break; } }
    }
    nloc = mine > 0u ? mine : 1u; nx = cnt > 0u ? cnt : 1u;
}

__device__ __forceinline__ void xcd_barrier(const XcdBarrier& b) {
    asm volatile("s_waitcnt vmcnt(0)" ::: "memory");
    __syncthreads();
    if (threadIdx.x == 0) {
        unsigned* bar = b.bar;
        __builtin_amdgcn_s_waitcnt(0);
        unsigned nloc = b.st[0], nx = b.st[1];
        if (nloc == 0u) { xcd_barrier_complete(bar, b.x, nloc, nx); b.st[0] = nloc; b.st[1] = nx; }
        const unsigned old = xb_add(&bar[XB_XSUB(b.x)], 1u);
        const unsigned gen = old / nloc;
        if (old + 1u == (gen + 1u) * nloc) {
            __builtin_amdgcn_fence(__ATOMIC_RELEASE, "agent");
            asm volatile("s_waitcnt vmcnt(0)" ::: "memory");
            const unsigned og = xb_add(&bar[XB_TOP], 1u);
            const unsigned tg = og / nx;
            if (og + 1u == (tg + 1u) * nx) xb_add(&bar[XB_TOPGEN], 1u);
            else XB_SPIN(xb_ld(&bar[XB_TOPGEN]) == tg, bar);
            __builtin_amdgcn_fence(__ATOMIC_ACQUIRE, "agent");
            xb_add(&bar[XB_XGEN(b.x)], 1u);
            asm volatile("s_waitcnt vmcnt(0)" ::: "memory");
        } else {
            XB_SPIN(xb_ld(&bar[XB_XGEN(b.x)]) == gen, bar);
            __builtin_amdgcn_fence(__ATOMIC_ACQUIRE, "agent");
            asm volatile("s_waitcnt vmcnt(0)" ::: "memory");
        }
    }
    __syncthreads();
}


__device__ __forceinline__ float wave_sum(float v) {
#pragma unroll
    for (int o = 1; o < 64; o <<= 1) v += __shfl_xor(v, o);
    return v;
}
__device__ __forceinline__ int inv_perm32(int x) { return ((x & 7) >> 2) * 16 + (x >> 3) * 4 + (x & 3); }
__device__ __forceinline__ int phys_up(int c) { const int bj = c / FF, h = c % FF; return (h >> 7) * 256 + bj * 128 + (h & 96) + inv_perm32(h & 31); }
__device__ __forceinline__ int phys_in(int c) {
    const int s = c >> 9, q = c & 511;
    if (s <= 1) { const int hh = q >> 7, dim = q & 127, n = dim >> 6, i = dim & 63; return (s << 9) + (hh << 7) + 32 * (i >> 4) + 16 * n + (i & 15); }
    if (s == 2) return c;
    return (c & ~31) + inv_perm32(c & 31);
}
template <int MAP> __device__ __forceinline__ void p0_transpose_item(const float* W, int K, int N, bf16* WT, LAS float* scr, int item, int lane) {
    const int nblk = N / 32, kb = item / nblk, nb = item % nblk, k0 = 64 * kb, n0 = 32 * nb;
#pragma unroll 8
    for (int i = 0; i < 32; ++i) { const int kk = 2 * i + (lane >> 5); scr[kk * 33 + (lane & 31)] = W[(size_t)(k0 + kk) * N + n0 + (lane & 31)]; }
    LDS_WAIT(); asm volatile("" ::: "memory");
    const int c = lane & 7;
#pragma unroll
    for (int j = 0; j < 4; ++j) { const int n = (lane >> 3) + 8 * j; const LAS float* s = scr + (8 * c) * 33 + n;
        v4u o; o.x = cvt_pk_bf16(s[0 * 33], s[1 * 33]); o.y = cvt_pk_bf16(s[2 * 33], s[3 * 33]); o.z = cvt_pk_bf16(s[4 * 33], s[5 * 33]); o.w = cvt_pk_bf16(s[6 * 33], s[7 * 33]);
        const int col = n0 + n, pr = MAP == 1 ? phys_up(col) : MAP == 2 ? phys_in(col) : col;
        *(GAS v4u*)(WT + (size_t)pr * K + k0 + 8 * c) = o; }
    LDS_WAIT(); asm volatile("" ::: "memory");
}
__device__ __forceinline__ void ln_row(float* row, const float* g, const float* b, bf16* orow, int lane) {
    f32x4* xr = (f32x4*)row + lane;
    f32x4 v[4]; float s = 0.f;
#pragma unroll
    for (int j = 0; j < 4; ++j) { v[j] = xr[64 * j]; s += (v[j].x + v[j].y) + (v[j].z + v[j].w); }
    const float mean = wave_sum(s) * (1.f / D); float s2 = 0.f;
#pragma unroll
    for (int j = 0; j < 4; ++j) { v[j] = v[j] - mean; s2 += (v[j].x * v[j].x + v[j].y * v[j].y) + (v[j].z * v[j].z + v[j].w * v[j].w); }
    const float rstd = 1.f / sqrtf(wave_sum(s2) * (1.f / D) + LN_EPS);
#pragma unroll
    for (int j = 0; j < 4; ++j) {
        const f32x4 gg = ((const f32x4*)g)[lane + 64 * j], bb = ((const f32x4*)b)[lane + 64 * j];
        const f32x4 o = v[j] * rstd * gg + bb;
        xr[64 * j] = o;
        if (orow) { v2u w; w.x = cvt_pk_bf16(o.x, o.y); w.y = cvt_pk_bf16(o.z, o.w); ((v2u*)orow)[lane + 64 * j] = w; }
    }
}
__device__ __forceinline__ void sincos_d(double a, double& sn, double& cs) {
    const double q = __builtin_rint(a * 0.63661977236758134308);
    double r = __builtin_fma(-q, 1.57079632679489655800e+00, a); r = __builtin_fma(-q, 6.12323399573676603587e-17, r);
    const double z = r * r;
    double ps = 1.0 / 6227020800.0; ps = __builtin_fma(ps, -z, 1.0 / 39916800.0); ps = __builtin_fma(ps, -z, 1.0 / 362880.0); ps = __builtin_fma(ps, -z, 1.0 / 5040.0); ps = __builtin_fma(ps, -z, 1.0 / 120.0); ps = __builtin_fma(ps, -z, 1.0 / 6.0); ps = __builtin_fma(ps, -z, 1.0);
    double pc = 1.0 / 87178291200.0; pc = __builtin_fma(pc, -z, 1.0 / 479001600.0); pc = __builtin_fma(pc, -z, 1.0 / 3628800.0); pc = __builtin_fma(pc, -z, 1.0 / 40320.0); pc = __builtin_fma(pc, -z, 1.0 / 720.0); pc = __builtin_fma(pc, -z, 1.0 / 24.0); pc = __builtin_fma(pc, -z, 0.5); pc = __builtin_fma(pc, -z, 1.0);
    const double s0 = r * ps, c0 = pc;
    const int k = ((int)q) & 3;
    sn = (k == 0) ? s0 : (k == 1) ? c0 : (k == 2) ? -s0 : -c0;
    cs = (k == 0) ? c0 : (k == 1) ? -s0 : (k == 2) ? -c0 : s0;
}

struct Args { const float* in[19]; float* out; unsigned char* ws; };

__device__ __forceinline__ void p0_prologue(const Args& a, LAS unsigned char* lds, int gw, int NGW, int wave, int lane) {
    unsigned char* ws = a.ws;
    LAS float* scr = (LAS float*)(lds + wave * 16384);
    constexpr int I_UP = (D / 64) * (NUP / 32), I_DN = (FF / 64) * (D / 32), I_IN = (D / 64) * (NIN / 32), I_OUT = (D / 64) * (D / 32);
    constexpr int NITEMS = 2 * I_UP + 2 * I_DN + I_IN + I_OUT;
    for (int it = gw; it < NITEMS; it += NGW) {
        int r = it;
        if (r < I_UP) { p0_transpose_item<1>(a.in[1], D, NUP, (bf16*)(ws + WS_W1U), scr, r, lane); continue; } r -= I_UP;
        if (r < I_UP) { p0_transpose_item<1>(a.in[15], D, NUP, (bf16*)(ws + WS_W2U), scr, r, lane); continue; } r -= I_UP;
        if (r < I_DN) { p0_transpose_item<0>(a.in[2], FF, D, (bf16*)(ws + WS_W1D), scr, r, lane); continue; } r -= I_DN;
        if (r < I_DN) { p0_transpose_item<0>(a.in[16], FF, D, (bf16*)(ws + WS_W2D), scr, r, lane); continue; } r -= I_DN;
        if (r < I_IN) { p0_transpose_item<2>(a.in[5], D, NIN, (bf16*)(ws + WS_WIN), scr, r, lane); continue; } r -= I_IN;
        p0_transpose_item<0>(a.in[12], D, D, (bf16*)(ws + WS_WOUT), scr, r, lane);
    }
    bf16* XB = (bf16*)(ws + WS_XB);
    for (int m = gw; m < M; m += NGW) {
        const f32x4* xr = (const f32x4*)(a.in[0] + (size_t)m * D) + lane; v2u* o = (v2u*)(XB + (size_t)m * D) + lane;
#pragma unroll
        for (int j = 0; j < 4; ++j) { const f32x4 v = xr[64 * j]; v2u w; w.x = cvt_pk_bf16(v.x, v.y); w.y = cvt_pk_bf16(v.z, v.w); o[64 * j] = w; }
    }
    float* rope = (float*)(ws + WS_ROPE);
    for (int e = gw * 64 + lane; e < SEQ * 64; e += NGW * 64) {
        const int pos = e >> 6, i = e & 63;
        double pw = 1.0, bs = 0.86596432336006535; for (int bit = 0; bit < 6; ++bit) { if ((i >> bit) & 1) pw *= bs; bs *= bs; }
        const float inv = (float)pw;
        const float ang = (float)pos * inv;
        double sn, cs; sincos_d((double)ang, sn, cs);
        rope[e] = (float)cs; rope[SEQ * 64 + e] = (float)sn;
    }
    bf16* TR = (bf16*)(ws + WS_TRIL);
    for (int e = gw * 64 + lane; e < 4 * 128 * 128; e += NGW * 64) { const int t = (e >> 7) & 127, s = e & 127; TR[e] = (bf16)(cvt_pk_bf16(s <= t ? a.in[10][e] : 0.f, 0.f) & 0xffffu); }
}

__device__ __forceinline__ void gmlp_unit(const Args& a, LAS unsigned char* lds, int unit, int tid, int wave, int lane) {
    unsigned char* ws = a.ws;
    const int g = unit & 3, c = (unit >> 2) & 63, b = unit >> 8;
    const bf16* ZT = (const bf16*)(ws + WS_ZT) + (size_t)((b * 4 + g) * 128) * SEQ + c * 128;
    const bf16* TR = (const bf16*)(ws + WS_TRIL) + g * 128 * 128;
    const bf16* U = (const bf16*)(ws + WS_U); bf16* CAT = (bf16*)(ws + WS_CAT);
    LAS float* red = (LAS float*)lds;
    LAS float* stat = (LAS float*)(lds + 4096);
    const int fr = lane & 15, fq = lane >> 4;
    __syncthreads();
    { const int tt = tid & 127, part = tid >> 7; float s = 0.f, s2 = 0.f;
#pragma unroll 8
      for (int ch = part * 32; ch < part * 32 + 32; ++ch) { const float v = bf2f(ZT[(size_t)ch * SEQ + tt]); s += v; s2 += v * v; }
      red[(part * 128 + tt) * 2] = s; red[(part * 128 + tt) * 2 + 1] = s2; }
    __syncthreads();
    if (tid < 128) { float s = 0.f, s2 = 0.f;
#pragma unroll
      for (int p = 0; p < 4; ++p) { s += red[(p * 128 + tid) * 2]; s2 += red[(p * 128 + tid) * 2 + 1]; }
      const float mean = s * (1.f / 128.f); float var = s2 * (1.f / 128.f) - mean * mean; var = var < 0.f ? 0.f : var;
      stat[tid * 2] = mean; stat[tid * 2 + 1] = 1.f / sqrtf(var + LN_EPS); }
    __syncthreads();
    const int ch = 16 * wave + fr; const float lg = a.in[8][g * 128 + ch], lb = a.in[9][g * 128 + ch];
    bf16x8 af[4];
#pragma unroll
    for (int ks = 0; ks < 4; ++ks) {
        const v4u raw = *(const v4u*)(ZT + (size_t)ch * SEQ + 32 * ks + 8 * fq);
        const unsigned rw[4] = {raw.x, raw.y, raw.z, raw.w}; unsigned o[4];
#pragma unroll
        for (int p = 0; p < 4; ++p) { const int s0 = 32 * ks + 8 * fq + 2 * p;
            const float z0 = __uint_as_float(rw[p] << 16), z1 = __uint_as_float(rw[p] & 0xffff0000u);
            const float y0 = (z0 - stat[s0 * 2]) * stat[s0 * 2 + 1] * lg + lb, y1 = (z1 - stat[s0 * 2 + 2]) * stat[s0 * 2 + 3] * lg + lb;
            o[p] = cvt_pk_bf16(y0, y1); }
        const v4u ov = {o[0], o[1], o[2], o[3]}; af[ks] = __builtin_bit_cast(bf16x8, ov);
    }
#pragma unroll 1
    for (int rt = 0; rt < 8; ++rt) {
        f32x4 acc = {0.f, 0.f, 0.f, 0.f};
        const int t = 16 * rt + fr;
#pragma unroll
        for (int ks = 0; ks < 4; ++ks) if (32 * ks <= 16 * rt + 15) {
            const bf16x8 bw = *(const bf16x8*)(TR + t * 128 + 32 * ks + 8 * fq);
            acc = __builtin_amdgcn_mfma_f32_16x16x32_bf16(af[ks], bw, acc, 0, 0, 0);
        }
        const float bs = a.in[11][g * 128 + t];
        const size_t tok = (size_t)b * SEQ + c * 128 + t;
        const v2u uu = *(const v2u*)(U + tok * MW + g * 128 + 16 * wave + 4 * fq);
        const float u0 = __uint_as_float(uu.x << 16), u1 = __uint_as_float(uu.x & 0xffff0000u), u2 = __uint_as_float(uu.y << 16), u3 = __uint_as_float(uu.y & 0xffff0000u);
        v2u w; w.x = cvt_pk_bf16(u0 * (acc[0] + bs), u1 * (acc[1] + bs)); w.y = cvt_pk_bf16(u2 * (acc[2] + bs), u3 * (acc[3] + bs));
        *(v2u*)(CAT + tok * D + 512 + g * 128 + 16 * wave + 4 * fq) = w;
    }
}
__device__ __forceinline__ void r1_unit(const Args& a, int unit, int wave, int lane) {
    unsigned char* ws = a.ws;
    const int n = unit & 31, bh = unit >> 5, fr = lane & 15, fq = lane >> 4;
    const bf16* VT = (const bf16*)(ws + WS_VT) + (size_t)(bh * 128) * SEQ + n * RC;
    const bf16* KT = (const bf16*)(ws + WS_KTZ) + (size_t)(bh * 128) * SEQ + n * RC;
    f32x4 acc[8];
#pragma unroll
    for (int t = 0; t < 8; ++t) acc[t] = (f32x4){0.f, 0.f, 0.f, 0.f};
#pragma unroll 2
    for (int ks = 0; ks < 8; ++ks) {
        const bf16x8 av = *(const bf16x8*)(VT + (size_t)(16 * wave + fr) * SEQ + 32 * ks + 8 * fq);
#pragma unroll
        for (int t = 0; t < 8; ++t) { const bf16x8 bk = *(const bf16x8*)(KT + (size_t)(16 * t + fr) * SEQ + 32 * ks + 8 * fq);
            acc[t] = __builtin_amdgcn_mfma_f32_16x16x32_bf16(av, bk, acc[t], 0, 0, 0); }
    }
    float* KV = (float*)(ws + WS_KV) + (size_t)unit * 16384;
#pragma unroll
    for (int t = 0; t < 8; ++t)
#pragma unroll
        for (int r = 0; r < 4; ++r) KV[(16 * wave + 4 * fq + r) * 128 + 16 * t + fr] = acc[t][r];
}
__device__ __forceinline__ void r3_unit(const Args& a, int bhn, int p16, int lane) {
    unsigned char* ws = a.ws;
    const int n = bhn & 31, bh = bhn >> 5, b = bh >> 2, h = bh & 3, fr = lane & 15, fq = lane >> 4;
    const size_t tok0 = (size_t)b * SEQ + n * RC;
    const bf16* Qt = (const bf16*)(ws + WS_QT) + tok0 * MW + h * 128;
    const bf16* Kt = (const bf16*)(ws + WS_KT) + tok0 * MW + h * 128;
    const bf16* VT = (const bf16*)(ws + WS_VT) + (size_t)(bh * 128) * SEQ + n * RC;
    const bf16* ST = (const bf16*)(ws + WS_ST) + (size_t)bhn * 16384;
    bf16x8 qf[4];
#pragma unroll
    for (int ks = 0; ks < 4; ++ks) qf[ks] = *(const bf16x8*)(Qt + (size_t)(16 * p16 + fr) * MW + 32 * ks + 8 * fq);
    f32x4 o[8];
#pragma unroll
    for (int t = 0; t < 8; ++t) o[t] = (f32x4){0.f, 0.f, 0.f, 0.f};
    if (n > 0) {
#pragma unroll
        for (int t = 0; t < 8; ++t)
#pragma unroll
            for (int ks = 0; ks < 4; ++ks) { const bf16x8 as = *(const bf16x8*)(ST + (16 * t + fr) * 128 + 32 * ks + 8 * fq);
                o[t] = __builtin_amdgcn_mfma_f32_16x16x32_bf16(as, qf[ks], o[t], 0, 0, 0); }
        const float gm = h == 0 ? 0.96875f : h == 1 ? 0.984375f : h == 2 ? 0.9921875f : 0.99609375f;
#pragma unroll
        for (int t = 0; t < 8; ++t) o[t] = o[t] * gm;
    }
    const int nst = (p16 >> 1) + 1;
#pragma unroll 1
    for (int st = 0; st < nst; ++st) {
        const int k0 = 32 * st;
        f32x4 s0 = {0.f, 0.f, 0.f, 0.f}, s1 = {0.f, 0.f, 0.f, 0.f};
#pragma unroll
        for (int ks = 0; ks < 4; ++ks) {
            const bf16x8 a0 = *(const bf16x8*)(Kt + (size_t)(k0 + fr) * MW + 32 * ks + 8 * fq);
            const bf16x8 a1 = *(const bf16x8*)(Kt + (size_t)(k0 + 16 + fr) * MW + 32 * ks + 8 * fq);
            s0 = __builtin_amdgcn_mfma_f32_16x16x32_bf16(a0, qf[ks], s0, 0, 0, 0);
            s1 = __builtin_amdgcn_mfma_f32_16x16x32_bf16(a1, qf[ks], s1, 0, 0, 0);
        }
        if (st == nst - 1) { const int qa = 16 * p16 + fr;
#pragma unroll
            for (int r = 0; r < 4; ++r) { if (k0 + 4 * fq + r > qa) s0[r] = 0.f; if (k0 + 16 + 4 * fq + r > qa) s1[r] = 0.f; } }
        const v4u pv = {cvt_pk_bf16(s0[0], s0[1]), cvt_pk_bf16(s0[2], s0[3]), cvt_pk_bf16(s1[0], s1[1]), cvt_pk_bf16(s1[2], s1[3])};
        const bf16x8 pk = __builtin_bit_cast(bf16x8, pv);
#pragma unroll
        for (int t = 0; t < 8; ++t) {
            const bf16* vp = VT + (size_t)(16 * t + fr) * SEQ + k0 + 4 * fq;
            const v2u lo = *(const v2u*)vp, hi = *(const v2u*)(vp + 16);
            const v4u av = {lo.x, lo.y, hi.x, hi.y};
            o[t] = __builtin_amdgcn_mfma_f32_16x16x32_bf16(__builtin_bit_cast(bf16x8, av), pk, o[t], 0, 0, 0);
        }
    }
    float s = 0.f;
#pragma unroll
    for (int t = 0; t < 8; ++t) s += (o[t][0] + o[t][1]) + (o[t][2] + o[t][3]);
    s += __shfl_xor(s, 16); s += __shfl_xor(s, 32);
    const float mean = s * (1.f / 128.f); float q = 0.f;
#pragma unroll
    for (int t = 0; t < 8; ++t) { o[t] = o[t] - mean; q += (o[t][0] * o[t][0] + o[t][1] * o[t][1]) + (o[t][2] * o[t][2] + o[t][3] * o[t][3]); }
    q += __shfl_xor(q, 16); q += __shfl_xor(q, 32);
    const float rstd = 1.f / sqrtf(q * (1.f / 128.f) + LN_EPS);
    const size_t tok = tok0 + 16 * p16 + fr;
    const bf16* G = (const bf16*)(ws + WS_G) + tok * MW + h * 128; bf16* CAT = (bf16*)(ws + WS_CAT) + tok * D + h * 128;
#pragma unroll
    for (int t = 0; t < 8; ++t) {
        const int dv = 16 * t + 4 * fq;
        const f32x4 gg = *(const f32x4*)(a.in[6] + h * 128 + dv), gb = *(const f32x4*)(a.in[7] + h * 128 + dv);
        const v2u gt = *(const v2u*)(G + dv);
        const float g0 = __uint_as_float(gt.x << 16), g1 = __uint_as_float(gt.x & 0xffff0000u), g2 = __uint_as_float(gt.y << 16), g3 = __uint_as_float(gt.y & 0xffff0000u);
        const f32x4 y = o[t] * rstd * gg + gb;
        v2u w; w.x = cvt_pk_bf16(g0 * y[0], g1 * y[1]); w.y = cvt_pk_bf16(g2 * y[2], g3 * y[3]);
        *(v2u*)(CAT + dv) = w;
    }
}

__global__ void __launch_bounds__(NWAVES * 64, 2) mk_fwd(Args args) {
    extern __shared__ __attribute__((aligned(16))) unsigned char lds_raw[];
    cg::grid_group grid = cg::this_grid();
    LAS unsigned char* lds = (LAS unsigned char*)lds_raw;
    const int tid = threadIdx.x, lane = tid & 63, wave = __builtin_amdgcn_readfirstlane(tid >> 6);
    const int G = gridDim.x, bx = blockIdx.x;
    const int gw = bx * NWAVES + wave, NGW = G * NWAVES;
    unsigned char* ws = args.ws;
    bf16* XB = (bf16*)(ws + WS_XB); bf16* HB = (bf16*)(ws + WS_H); bf16* CAT = (bf16*)(ws + WS_CAT);
    float* out = args.out;
    { volatile LAS unsigned* z = (volatile LAS unsigned*)(lds + 131072); if (tid < 64) z[tid] = 0u; }
    __syncthreads();
    const XcdBarrier xbar = xcd_barrier_post((unsigned*)ws, (volatile LAS unsigned*)(lds + 131072 + 32));
#define GRID_BAR() xcd_barrier(xbar)

    p0_prologue(args, lds, gw, NGW, wave, lane);
    grid.sync();
    { pg8::Gemm g{XB, (const bf16*)(ws + WS_W1U), M, NUP, D}; pg8::StaticOrder S; S.init(M, NUP, G, bx); pg8::EpiUp E{HB, FF};
      pg8::gemm_phase<pg8::EpiUp, pg8::StaticOrder, true, true>(lds, g, S, E); }
    GRID_BAR();
    { pg8::Gemm g{HB, (const bf16*)(ws + WS_W1D), M, D, FF}; pg8::StaticOrder S; S.init(M, D, G, bx); pg8::EpiRes E{args.in[0], out, ALPHA, 0.5f};
      pg8::gemm_phase<pg8::EpiRes, pg8::StaticOrder, true, true>(lds, g, S, E); }
    GRID_BAR();
    for (int m = gw; m < M; m += NGW) ln_row(out + (size_t)m * D, args.in[3], args.in[4], XB + (size_t)m * D, lane);
    GRID_BAR();
    { pg8::Gemm g{XB, (const bf16*)(ws + WS_WIN), M, NIN, D}; pg8::StaticOrder S; S.init(M, NIN, G, bx);
      pg8::EpiIn E{(bf16*)(ws + WS_QT), (bf16*)(ws + WS_KT), (bf16*)(ws + WS_KTZ), (bf16*)(ws + WS_VT), (bf16*)(ws + WS_G), (bf16*)(ws + WS_U), (bf16*)(ws + WS_ZT), (const float*)(ws + WS_ROPE)};
      pg8::gemm_phase<pg8::EpiIn, pg8::StaticOrder, true, true>(lds, g, S, E); }
    GRID_BAR();
    for (int u = bx; u < BATCH * 64 * 4; u += G) gmlp_unit(args, lds, u, tid, wave, lane);
    for (int u = bx; u < 32 * NCH; u += G) r1_unit(args, u, wave, lane);
    GRID_BAR();
    { const float* KV = (const float*)(ws + WS_KV); bf16* ST = (bf16*)(ws + WS_ST);
      for (int e = bx * (NWAVES * 64) + tid; e < 32 * 4096; e += G * NWAVES * 64) {
        const int bh = e >> 12, off = (e & 4095) * 4, h = bh & 3;
        const float gc = h == 0 ? 0.0002952562990352836f : h == 1 ? 0.017746279621051256f : h == 2 ? 0.13427659965015967f : 0.36715975489153624f;
        f32x4 s = {0.f, 0.f, 0.f, 0.f};
#pragma unroll 4
        for (int n = 0; n < NCH - 1; ++n) {
            const f32x4 kv = *(const f32x4*)(KV + (size_t)(bh * NCH + n) * 16384 + off);
            s = s * gc + kv;
            v2u w; w.x = cvt_pk_bf16(s.x, s.y); w.y = cvt_pk_bf16(s.z, s.w);
            *(v2u*)(ST + (size_t)(bh * NCH + n + 1) * 16384 + off) = w;
        } } }
    GRID_BAR();
    for (int k = 0; k < 8; ++k) {
        const int g2 = gw, q = g2 & 15, p16 = (k & 1) ? 15 - q : q, bhn = (g2 >> 4) + 128 * k;
        if (NGW == 2048) r3_unit(args, bhn, p16, lane);
    }
    if (NGW != 2048) { for (int u = gw; u < 16384; u += NGW) r3_unit(args, u >> 4, u & 15, lane); }
    GRID_BAR();
    { pg8::Gemm g{CAT, (const bf16*)(ws + WS_WOUT), M, D, D}; pg8::StaticOrder S; S.init(M, D, G, bx); pg8::EpiRes E{out, out, ALPHA, 1.0f};
      pg8::gemm_phase<pg8::EpiRes, pg8::StaticOrder, true, true>(lds, g, S, E); }
    GRID_BAR();
    for (int m = gw; m < M; m += NGW) ln_row(out + (size_t)m * D, args.in[13], args.in[14], XB + (size_t)m * D, lane);
    GRID_BAR();
    { pg8::Gemm g{XB, (const bf16*)(ws + WS_W2U), M, NUP, D}; pg8::StaticOrder S; S.init(M, NUP, G, bx); pg8::EpiUp E{HB, FF};
      pg8::gemm_phase<pg8::EpiUp, pg8::StaticOrder, true, true>(lds, g, S, E); }
    GRID_BAR();
    { pg8::Gemm g{HB, (const bf16*)(ws + WS_W2D), M, D, FF}; pg8::StaticOrder S; S.init(M, D, G, bx); pg8::EpiRes E{out, out, ALPHA, 0.5f};
      pg8::gemm_phase<pg8::EpiRes, pg8::StaticOrder, true, true>(lds, g, S, E); }
    GRID_BAR();
    for (int m = gw; m < M; m += NGW) ln_row(out + (size_t)m * D, args.in[17], args.in[18], nullptr, lane);
}

extern "C" void kernel_launch(void* const* d_in, const int* in_sizes, int n_in, void* d_out, int out_size, void* d_ws, size_t ws_size, hipStream_t stream) {
    static int grid = 0;
    if (grid == 0) {
        if (n_in != 19 || out_size != M * D || ws_size < WS_END) { fprintf(stderr, "kernel_launch: unexpected shapes n_in %d out %d ws %zu\n", n_in, out_size, ws_size); grid = -1; return; }
        int dev = 0, cus = 0, per_cu = 0;
        (void)hipGetDevice(&dev); (void)hipDeviceGetAttribute(&cus, hipDeviceAttributeMultiprocessorCount, dev);
        if (hipFuncSetAttribute((const void*)mk_fwd, hipFuncAttributeMaxDynamicSharedMemorySize, LDS_BYTES) != hipSuccess) { fprintf(stderr, "kernel_launch: hipFuncSetAttribute failed\n"); grid = -1; return; }
        (void)hipOccupancyMaxActiveBlocksPerMultiprocessor(&per_cu, (const void*)mk_fwd, NWAVES * 64, LDS_BYTES);
        if (per_cu < 1) { fprintf(stderr, "kernel_launch: occupancy query says %d\n", per_cu); per_cu = 1; }
        (void)hipGetLastError();
        grid = cus;
    }
    if (grid < 0) return;
    if (hipMemsetAsync(d_ws, 0, 16384, stream) != hipSuccess) { fprintf(stderr, "kernel_launch: memset failed\n"); return; }
    Args a{};
    for (int i = 0; i < 19; ++i) a.in[i] = (const float*)d_in[i];
    a.out = (float*)d_out; a.ws = (unsigned char*)d_ws;
    void* kargs[] = {&a};
    hipError_t e = hipLaunchCooperativeKernel((const void*)mk_fwd, dim3(grid), dim3(NWAVES * 64), kargs, LDS_BYTES, stream);
    if (e != hipSuccess) fprintf(stderr, "cooperative launch failed: %s (grid %d)\n", hipGetErrorString(e), grid);
}
```
